# Optimizing an MI355X kernel written in HIP

```python
import math
import jax, jax.numpy as jnp
from jax import lax
import numpy as np

D_MODEL = 1024
BATCH = 8
SEQ = 4096
DEPTH = 1
DEC_BATCH = 8
DEC_SEQ = 8192
PAST_LEN = 128

HEAD_DIM = 64
H_A = 8
H_B = 8
KVH_B = 2
G_B = H_B // KVH_B
W_A = H_A * HEAD_DIM
W_B = H_B * HEAD_DIM
W_KV_B = KVH_B * HEAD_DIM
GRID_W = 64
NA_ROWS = 8
NA_COLS = 16
WINDOW = 128
BLOCK = 128
T5_BUCKETS = 32
T5_MAX_DIST = 128
EPS = 1e-6
SPLITS = (W_A, W_A, W_A, W_A, W_B, W_KV_B, W_KV_B, W_B, D_MODEL, D_MODEL)
D_IN = sum(SPLITS)

kernel_name = "hybrid_natten_window_gqa_gated_encoder"


def rmsnorm(x, g):
    xf = x.astype(jnp.float32)
    y = xf * lax.rsqrt(jnp.mean(xf * xf, axis=-1, keepdims=True) + EPS)
    return (y * g.astype(jnp.float32)).astype(x.dtype)


def t5_bucket(rel):
    half = T5_BUCKETS // 2
    max_exact = half // 2
    n = jnp.abs(rel)
    large = max_exact + (jnp.log(jnp.maximum(n, 1).astype(jnp.float32) / max_exact)
                         / math.log(T5_MAX_DIST / max_exact) * (half - max_exact)).astype(jnp.int32)
    large = jnp.minimum(large, half - 1)
    return jnp.where(rel > 0, half, 0) + jnp.where(n < max_exact, n, large)


def neighbourhood_attention(q, k, v, rpb):
    B, L, H, dh = q.shape
    rows = L // GRID_W
    kr = min(NA_ROWS, rows)
    qg = q.reshape(B, rows, GRID_W, H, dh)
    kg = k.reshape(B, rows, GRID_W, H, dh)
    vg = v.reshape(B, rows, GRID_W, H, dh)
    col = np.arange(GRID_W)
    cs = np.clip(col - NA_COLS // 2, 0, GRID_W - NA_COLS)
    cidx = cs[:, None] + np.arange(NA_COLS)[None, :]
    dc_idx = (cidx - col[:, None]) + (NA_COLS - 1)
    scale = 1.0 / math.sqrt(dh)

    def row_step(args):
        r, q_r = args
        rs = jnp.clip(r - kr // 2, 0, rows - kr)
        k_rows = lax.dynamic_slice_in_dim(kg, rs, kr, axis=1)
        v_rows = lax.dynamic_slice_in_dim(vg, rs, kr, axis=1)
        k_n = k_rows[:, :, cidx]
        v_n = v_rows[:, :, cidx]
        dr_idx = rs + jnp.arange(kr) - r + (NA_ROWS - 1)
        bias = rpb[:, dr_idx[None, :, None], dc_idx[:, None, :]]
        s = jnp.einsum('bqhd,brqchd->bhqrc', q_r, k_n).astype(jnp.float32) * scale
        s = s + bias[None].astype(jnp.float32)
        p = jax.nn.softmax(s.reshape(B, H, GRID_W, kr * NA_COLS), axis=-1)
        p = p.reshape(B, H, GRID_W, kr, NA_COLS).astype(v.dtype)
        return jnp.einsum('bhqrc,brqchd->bqhd', p, v_n)

    q_rows = jnp.moveaxis(qg, 1, 0)
    out = lax.map(row_step, (jnp.arange(rows), q_rows))
    return jnp.moveaxis(out, 0, 1).reshape(B, L, H * dh)


def window_gqa_attention(q, k, v, t5_table, sink):
    B, L, H, dh = q.shape
    nb = L // BLOCK
    pad = ((0, 0), (BLOCK, BLOCK), (0, 0), (0, 0))
    kp = jnp.pad(k, pad).reshape(B, nb + 2, BLOCK, KVH_B, dh)
    vp = jnp.pad(v, pad).reshape(B, nb + 2, BLOCK, KVH_B, dh)
    kb = jnp.concatenate([kp[:, :-2], kp[:, 1:-1], kp[:, 2:]], axis=2)
    vb = jnp.concatenate([vp[:, :-2], vp[:, 1:-1], vp[:, 2:]], axis=2)
    qb = q.reshape(B, nb, BLOCK, KVH_B, G_B, dh)
    scale = 1.0 / math.sqrt(dh)
    s = jnp.einsum('bnqkgd,bnskd->bnkgqs', qb, kb).astype(jnp.float32) * scale
    sidx = jnp.arange(3 * BLOCK)
    rel = sidx[None, :] - BLOCK - jnp.arange(BLOCK)[:, None]
    key_pos = jnp.arange(nb)[:, None] * BLOCK + sidx[None, :] - BLOCK
    mask = (jnp.abs(rel) <= WINDOW)[None] & ((key_pos >= 0) & (key_pos < L))[:, None, :]
    bias = jnp.transpose(t5_table[t5_bucket(rel)], (2, 0, 1)).reshape(KVH_B, G_B, BLOCK, 3 * BLOCK)
    s = s + bias[None, None].astype(jnp.float32)
    s = jnp.where(mask[None, :, None, None], s, jnp.float32(-1e30))
    sink_l = jnp.broadcast_to(sink.astype(jnp.float32).reshape(1, 1, KVH_B, G_B, 1, 1),
                              s.shape[:-1] + (1,))
    p = jax.nn.softmax(jnp.concatenate([s, sink_l], axis=-1), axis=-1)[..., :-1].astype(v.dtype)
    o = jnp.einsum('bnkgqs,bnskd->bnqkgd', p, vb)
    return o.reshape(B, L, H * dh)


def encoder_layer(x, norm_g, w_in, qn_a, kn_a, rpb_a, qn_b, kn_b, sink_b, w_o_a, w_o_b, w_out, t5_table):
    B, L, D = x.shape
    h = rmsnorm(x, norm_g)
    proj = h @ w_in
    qa, ka, va, za, qb, kb, vb, zb, ga, gb = jnp.split(proj, np.cumsum(SPLITS)[:-1], axis=-1)
    qa = rmsnorm(qa.reshape(B, L, H_A, HEAD_DIM), qn_a)
    ka = rmsnorm(ka.reshape(B, L, H_A, HEAD_DIM), kn_a)
    va = va.reshape(B, L, H_A, HEAD_DIM)
    oa = neighbourhood_attention(qa, ka, va, rpb_a) * jax.nn.silu(za)
    oa = oa @ w_o_a
    qb = rmsnorm(qb.reshape(B, L, H_B, HEAD_DIM), qn_b)
    kb = rmsnorm(kb.reshape(B, L, KVH_B, HEAD_DIM), kn_b)
    vb = vb.reshape(B, L, KVH_B, HEAD_DIM)
    ob = window_gqa_attention(qb, kb, vb, t5_table, sink_b) * jax.nn.silu(zb)
    ob = ob @ w_o_b
    merged = jax.nn.sigmoid(ga) * oa + jax.nn.sigmoid(gb) * ob
    return x + merged @ w_out


def setup_inputs(seed: int = 0) -> dict:
    key = jax.random.key(seed)
    ks = jax.random.split(key, 16)
    f32 = jnp.float32
    nrm = lambda k, shape, s: jax.random.normal(k, shape, f32) * s
    return {
        "x_prompt": nrm(ks[0], (BATCH, SEQ, D_MODEL), 1.0),
        "x_sample": nrm(ks[1], (DEC_BATCH, DEC_SEQ, D_MODEL), 1.0),
        "norm_g": 1.0 + nrm(ks[2], (DEPTH, D_MODEL), 0.02),
        "w_in": nrm(ks[3], (DEPTH, D_MODEL, D_IN), D_MODEL ** -0.5),
        "qn_a": 1.0 + nrm(ks[4], (DEPTH, HEAD_DIM), 0.02),
        "kn_a": 1.0 + nrm(ks[5], (DEPTH, HEAD_DIM), 0.02),
        "rpb_a": nrm(ks[6], (DEPTH, H_A, 2 * NA_ROWS - 1, 2 * NA_COLS - 1), 0.1),
        "qn_b": 1.0 + nrm(ks[7], (DEPTH, HEAD_DIM), 0.02),
        "kn_b": 1.0 + nrm(ks[8], (DEPTH, HEAD_DIM), 0.02),
        "sink_b": nrm(ks[9], (DEPTH, H_B), 0.5),
        "w_o_a": nrm(ks[10], (DEPTH, W_A, D_MODEL), W_A ** -0.5),
        "w_o_b": nrm(ks[11], (DEPTH, W_B, D_MODEL), W_B ** -0.5),
        "w_out": nrm(ks[12], (DEPTH, D_MODEL, D_MODEL), D_MODEL ** -0.5),
        "t5_table": nrm(ks[13], (T5_BUCKETS, H_B), 0.1),
    }


def reference(x_prompt, x_sample, norm_g, w_in, qn_a, kn_a, rpb_a, qn_b, kn_b, sink_b,
              w_o_a, w_o_b, w_out, t5_table):
    y_prompt = x_prompt
    y_sample = x_sample
    for l in range(DEPTH):
        params = (norm_g[l], w_in[l], qn_a[l], kn_a[l], rpb_a[l], qn_b[l], kn_b[l], sink_b[l],
                  w_o_a[l], w_o_b[l], w_out[l], t5_table)
        y_prompt = encoder_layer(y_prompt, *params)
        y_sample = encoder_layer(y_sample, *params)
    return (y_prompt, y_sample)
```

```cpp
#include <hip/hip_runtime.h>
#include <cstdio>
#include <cstdint>
namespace pg8 {
#define PG8_LAS __attribute__((address_space(3)))
typedef unsigned short bf16_t;
typedef short bf16x8 __attribute__((ext_vector_type(8)));
typedef float f32x4 __attribute__((ext_vector_type(4)));
typedef unsigned u32x4 __attribute__((ext_vector_type(4)));
typedef int i32x4 __attribute__((ext_vector_type(4)));
constexpr int BM = 256, BK = 64, HALF = 128, HTB = HALF * BK * 2  , STAGE_BYTES = 8 * HTB, NXCD = 8, WGM = 8;

__host__ __device__ __forceinline__ int lds_byte(int r, int c) { const int st = (r >> 4) * 2 + (c >> 5), rr = r & 15, cc = c & 31, ob = rr * 64 + cc * 2; return st * 1024 + (ob ^ (((ob >> 9) & 1) << 5)); }
__host__ __device__ __forceinline__ void stage_rc(int b, int& R, int& C) { const int st = b / 1024, sb = b % 1024, swz = sb ^ (((sb >> 9) & 1) << 5); R = (st >> 1) * 16 + swz / 64; C = (st & 1) * 32 + (swz % 64) / 2; }
__host__ __device__ __forceinline__ int perm32(int rho) { const int n = rho >> 4, i = rho & 15; return 8 * (i >> 2) + 4 * n + (i & 3); }

struct Unit { int pm, pn, kh; };
struct Gemm { const bf16_t* A; const bf16_t* Bt; int lda, ldb, K; };

struct StaticOrder {
    int nM, nN, nwg, G, c, ks;
    __host__ __device__ void init(int M, int N, int G_, int c_, int ks_ = 1) { nM = M / BM; nN = N / BM; nwg = nM * nN; G = G_; c = c_; ks = ks_; }
    __host__ __device__ bool next(int i, Unit& u) const {
        const int it = (ks == 2) ? (i >> 1) : i; u.kh = (ks == 2) ? (i & 1) : 0;
        const long L = (long)it * G + c; if (L >= nwg) return false;
        int wgid = (int)L; { const int q = nwg / NXCD, r = nwg % NXCD, xcd = wgid % NXCD, off = wgid / NXCD; wgid = (xcd < r ? xcd * (q + 1) : r * (q + 1) + (xcd - r) * q) + off; }
        const int nig = WGM * nN, gid = wgid / nig, fm = gid * WGM, gsz = (nM - fm) < WGM ? (nM - fm) : WGM;
        u.pm = fm + ((wgid % nig) % gsz); u.pn = (wgid % nig) / gsz; return true;
    }
    __device__ __forceinline__ void a_ready(const Unit&) const {}
    __device__ __forceinline__ void done(const Unit&) const {}
};

__device__ __forceinline__ unsigned cvt_pk_bf16(float lo, float hi) { unsigned r; asm volatile("v_cvt_pk_bf16_f32 %0, %1, %2" : "=v"(r) : "v"(lo), "v"(hi)); return r; }
__device__ __forceinline__ float bf_lo(unsigned w) { return __uint_as_float(w << 16); }
__device__ __forceinline__ float bf_hi(unsigned w) { return __uint_as_float(w & 0xffff0000u); }
__device__ __forceinline__ float sigmoidf_(float v) { return __builtin_amdgcn_rcpf(1.0f + __builtin_amdgcn_exp2f(-1.4426950408889634f * v)); }

constexpr float C2 = 0.125f * 1.4426950408889634f;
constexpr float LOG2E = 1.4426950408889634f;

__device__ __forceinline__ void swap8(u32x4& a, u32x4& b, bool up) {
    const u32x4 send = up ? a : b; u32x4 recv;
#pragma unroll
    for (int k = 0; k < 4; ++k) recv[k] = (unsigned)__builtin_amdgcn_mov_dpp((int)send[k], 0x128, 0xf, 0xf, false);
    const u32x4 first = up ? recv : a, second = up ? b : recv; a = first; b = second;
}
__device__ __forceinline__ void swap8f(f32x4& a, f32x4& b, bool up) { u32x4 x = __builtin_bit_cast(u32x4, a), y = __builtin_bit_cast(u32x4, b); swap8(x, y, up); a = __builtin_bit_cast(f32x4, x); b = __builtin_bit_cast(f32x4, y); }

__device__ __forceinline__ void proj_rows(f32x4 (&v)[2][2], bool norm, float sc, const f32x4 (&wv)[2][2], bf16_t* rowp, size_t ld, bool up) {
    if (norm) {
        float ss = 0.f;
#pragma unroll
        for (int bj = 0; bj < 2; ++bj)
#pragma unroll
            for (int n = 0; n < 2; ++n) { const f32x4 x = v[bj][n]; ss += (x[0] * x[0] + x[1] * x[1]) + (x[2] * x[2] + x[3] * x[3]); }
        ss += __shfl_xor(ss, 16); ss += __shfl_xor(ss, 32);
        const float rs = __builtin_amdgcn_rsqf(ss * (1.0f / 64.0f) + 1e-6f) * sc;
#pragma unroll
        for (int bj = 0; bj < 2; ++bj)
#pragma unroll
            for (int n = 0; n < 2; ++n) v[bj][n] = v[bj][n] * rs * wv[bj][n];
    }
    u32x4 o0, o1;
    o0.x = cvt_pk_bf16(v[0][0][0], v[0][0][1]); o0.y = cvt_pk_bf16(v[0][0][2], v[0][0][3]); o0.z = cvt_pk_bf16(v[0][1][0], v[0][1][1]); o0.w = cvt_pk_bf16(v[0][1][2], v[0][1][3]);
    o1.x = cvt_pk_bf16(v[1][0][0], v[1][0][1]); o1.y = cvt_pk_bf16(v[1][0][2], v[1][0][3]); o1.z = cvt_pk_bf16(v[1][1][0], v[1][1][1]); o1.w = cvt_pk_bf16(v[1][1][2], v[1][1][3]);
    swap8(o0, o1, up);
    __builtin_nontemporal_store(o0, (u32x4*)rowp); __builtin_nontemporal_store(o1, (u32x4*)(rowp + (size_t)8 * ld));
}
struct EpiProjI8 {
    static constexpr bool PERM = true, AFTER_DRAIN = false;
    bf16_t *QA, *KA, *VA, *ZA, *QB, *KVB, *ZB; unsigned char* G8; const PG8_LAS float* wL; const float* rowscale; const PG8_LAS float* csL; PG8_LAS float* rsL;
    struct Pre {};
    __device__ __forceinline__ void preload(Pre&, const Unit& u, int wr, int wc, int fr, int fq) const {
        if (wr == 0 && wc == 0) __builtin_amdgcn_global_load_lds((const unsigned*)(rowscale + u.pm * BM + (fq * 16 + fr) * 4), (PG8_LAS unsigned*)rsL, 16, 0, 0);
    }
    __device__ __forceinline__ static float sum_fq(float x) {
        { auto rr = __builtin_amdgcn_permlane16_swap(__float_as_uint(x), __float_as_uint(x), false, false); x = __uint_as_float(rr[0]) + __uint_as_float(rr[1]); }
        { auto rr = __builtin_amdgcn_permlane32_swap(__float_as_uint(x), __float_as_uint(x), false, false); x = __uint_as_float(rr[0]) + __uint_as_float(rr[1]); }
        return x;
    }
    __device__ __forceinline__ void operator()(const f32x4 (&acc)[2][2][4][2], const Unit& u, int wr, int wc, int fr, int fq, const Pre&) const {
        const int pn = u.pn;
        const bool up = (fr & 8) != 0;
        float rs[8];
#pragma unroll
        for (int g = 0; g < 8; ++g) rs[g] = rsL[(g >> 2) * HALF + wr * 64 + (g & 3) * 16 + fr];
        f32x4 csv[2][2];
#pragma unroll
        for (int bj = 0; bj < 2; ++bj)
#pragma unroll
            for (int n = 0; n < 2; ++n) csv[bj][n] = *(const PG8_LAS f32x4*)(csL + pn * BM + wc * 64 + 32 * bj + 8 * fq + 4 * n);
        if (pn >= 13) {
            unsigned char* gp = G8 + (size_t)(u.pm * 8 + (pn - 13)) * 65536 + (size_t)(((wr * 4 + wc) * 64) + fq * 16 + fr) * 16;
#pragma unroll
            for (int bj = 0; bj < 2; ++bj)
#pragma unroll
                for (int n = 0; n < 2; ++n) csv[bj][n] = csv[bj][n] * -LOG2E;
#pragma unroll
            for (int g = 0; g < 8; ++g) {
                const float rsc = rs[g];
                u32x4 o;
#pragma unroll
                for (int bj = 0; bj < 2; ++bj)
#pragma unroll
                    for (int n = 0; n < 2; ++n) {
                        f32x4 x = __builtin_convertvector(__builtin_bit_cast(i32x4, acc[g >> 2][bj][g & 3][n]), f32x4) * (csv[bj][n] * rsc);
#pragma unroll
                        for (int i = 0; i < 4; ++i) x[i] = __builtin_amdgcn_exp2f(x[i]);
                        x = x + 1.0f;
#pragma unroll
                        for (int i = 0; i < 4; ++i) x[i] = __builtin_amdgcn_rcpf(x[i]);
                        x = x * 255.0f + 0.5f;
                        o[bj * 2 + n] = (unsigned)x[0] | ((unsigned)x[1] << 8) | ((unsigned)x[2] << 16) | ((unsigned)x[3] << 24); }
                __builtin_nontemporal_store(o, (u32x4*)(gp + g * 8192));
            }
            return;
        }
        bf16_t* base; int ld = 512, coff; int w = 64; bool norm = false; float sc = 1.0f;
        if (pn < 2)        { base = QA;  coff = pn * 256;        norm = true; w = 0; sc = C2; }
        else if (pn < 4)   { base = KA;  coff = (pn - 2) * 256;  norm = true; w = 64; }
        else if (pn < 6)   { base = VA;  coff = (pn - 4) * 256; }
        else if (pn < 8)   { base = ZA;  coff = (pn - 6) * 256; }
        else if (pn < 10)  { base = QB;  coff = (pn - 8) * 256;  norm = true; w = 128; sc = C2; }
        else if (pn == 10) { base = KVB; ld = 256; coff = 0;     norm = wc < 2; w = 192; }
        else               { base = ZB;  coff = (pn - 11) * 256; }
        const int col0 = coff + wc * 64 + 8 * fq + (up ? 32 : 0);
        const size_t ldz = (size_t)ld;
        bf16_t* const p0 = base + (size_t)(u.pm * BM + wr * 64 + (fr & 7)) * ldz + col0;
        f32x4 wv[2][2];
#pragma unroll
        for (int bj = 0; bj < 2; ++bj)
#pragma unroll
            for (int n = 0; n < 2; ++n) wv[bj][n] = *(const PG8_LAS f32x4*)(wL + w + 32 * bj + 8 * fq + 4 * n) * sc;
#pragma unroll
        for (int g = 0; g < 8; ++g) {
            const float r = rs[g];
            f32x4 v[2][2];
            if (norm) {
#pragma unroll
                for (int bj = 0; bj < 2; ++bj)
#pragma unroll
                    for (int n = 0; n < 2; ++n) v[bj][n] = __builtin_convertvector(__builtin_bit_cast(i32x4, acc[g >> 2][bj][g & 3][n]), f32x4) * csv[bj][n];
                f32x4 s4 = v[0][0] * v[0][0];
                s4 = __builtin_elementwise_fma(v[0][1], v[0][1], s4); s4 = __builtin_elementwise_fma(v[1][0], v[1][0], s4); s4 = __builtin_elementwise_fma(v[1][1], v[1][1], s4);
                const float ss = sum_fq((s4[0] + s4[1]) + (s4[2] + s4[3]));
                const float f = r * __builtin_amdgcn_rsqf((r * r) * ss * (1.0f / 64.0f) + 1e-6f);
#pragma unroll
                for (int bj = 0; bj < 2; ++bj)
#pragma unroll
                    for (int n = 0; n < 2; ++n) v[bj][n] = v[bj][n] * (wv[bj][n] * f);
            } else {
#pragma unroll
                for (int bj = 0; bj < 2; ++bj)
#pragma unroll
                    for (int n = 0; n < 2; ++n) v[bj][n] = __builtin_convertvector(__builtin_bit_cast(i32x4, acc[g >> 2][bj][g & 3][n]), f32x4) * (csv[bj][n] * r);
            }
            u32x4 o0, o1;
            o0.x = cvt_pk_bf16(v[0][0][0], v[0][0][1]); o0.y = cvt_pk_bf16(v[0][0][2], v[0][0][3]); o0.z = cvt_pk_bf16(v[0][1][0], v[0][1][1]); o0.w = cvt_pk_bf16(v[0][1][2], v[0][1][3]);
            o1.x = cvt_pk_bf16(v[1][0][0], v[1][0][1]); o1.y = cvt_pk_bf16(v[1][0][2], v[1][0][3]); o1.z = cvt_pk_bf16(v[1][1][0], v[1][1][1]); o1.w = cvt_pk_bf16(v[1][1][2], v[1][1][3]);
            swap8(o0, o1, up);
            bf16_t* rowp = p0 + (size_t)((g >> 2) * HALF + (g & 3) * 16) * ldz;
            __builtin_nontemporal_store(o0, (u32x4*)rowp); __builtin_nontemporal_store(o1, (u32x4*)(rowp + 8 * ldz));
        }
    }
};

struct EpiMerge {
    static constexpr bool PERM = true, AFTER_DRAIN = false;
    bf16_t* U; const unsigned char* G8;
    struct Pre {}; __device__ __forceinline__ void preload(Pre&, const Unit&, int, int, int, int) const {}
    __device__ __forceinline__ static f32x4 ub4(unsigned w) { return (f32x4){(float)(w & 255u), (float)((w >> 8) & 255u), (float)((w >> 16) & 255u), (float)(w >> 24)}; }
    __device__ __forceinline__ void mid(f32x4 (&acc)[2][2][4][2], const Unit& u, int wr, int wc, int fr, int fq) const {
        const unsigned char* ga = G8 + (size_t)(u.pm * 8 + u.pn) * 65536 + (size_t)(((wr * 4 + wc) * 64) + fq * 16 + fr) * 16;
        const unsigned char* gb = ga + 4 * 65536;
        u32x4 qa = *(const u32x4*)ga, qb = *(const u32x4*)gb;
#pragma unroll
        for (int c = 0; c < 8; ++c) {
            const u32x4 ca = qa, cb = qb;
            if (c + 1 < 8) { qa = *(const u32x4*)(ga + (c + 1) * 8192); qb = *(const u32x4*)(gb + (c + 1) * 8192); }
#pragma unroll
            for (int bj = 0; bj < 2; ++bj)
#pragma unroll
                for (int n = 0; n < 2; ++n) { const f32x4 a = ub4(ca[bj * 2 + n]); f32x4 b = ub4(cb[bj * 2 + n]);
#pragma unroll
                    for (int i = 0; i < 4; ++i) b[i] = __builtin_amdgcn_rcpf(fmaxf(b[i], 1.0f));
                    acc[c >> 2][bj][c & 3][n] = acc[c >> 2][bj][c & 3][n] * (a * b); }
        }
    }
    __device__ __forceinline__ void operator()(f32x4 (&acc)[2][2][4][2], const Unit& u, int wr, int wc, int fr, int fq, const Pre&) const {
        if (u.kh == 0) { mid(acc, u, wr, wc, fr, fq); return; }
        const unsigned char* gb = G8 + (size_t)(u.pm * 8 + 4 + u.pn) * 65536 + (size_t)(((wr * 4 + wc) * 64) + fq * 16 + fr) * 16;
        const bool up = (fr & 8) != 0;
        const int col0 = u.pn * BM + wc * 64 + 8 * fq + (up ? 32 : 0);
        const size_t rowb = (size_t)(u.pm * BM + wr * 64 + (fr & 7));
        u32x4 qb[8];
#pragma unroll
        for (int c = 0; c < 8; ++c) qb[c] = *(const u32x4*)(gb + c * 8192);
#pragma unroll
        for (int ai = 0; ai < 2; ++ai)
#pragma unroll
            for (int m = 0; m < 4; ++m) {
                f32x4 v[2][2];
#pragma unroll
                for (int bj = 0; bj < 2; ++bj)
#pragma unroll
                    for (int n = 0; n < 2; ++n) v[bj][n] = acc[ai][bj][m][n] * (__builtin_elementwise_max(ub4(qb[ai * 4 + m][bj * 2 + n]), (f32x4){1.f, 1.f, 1.f, 1.f}) * (1.0f / 255.0f));
                u32x4 o0, o1;
                o0.x = cvt_pk_bf16(v[0][0][0], v[0][0][1]); o0.y = cvt_pk_bf16(v[0][0][2], v[0][0][3]); o0.z = cvt_pk_bf16(v[0][1][0], v[0][1][1]); o0.w = cvt_pk_bf16(v[0][1][2], v[0][1][3]);
                o1.x = cvt_pk_bf16(v[1][0][0], v[1][0][1]); o1.y = cvt_pk_bf16(v[1][0][2], v[1][0][3]); o1.z = cvt_pk_bf16(v[1][1][0], v[1][1][1]); o1.w = cvt_pk_bf16(v[1][1][2], v[1][1][3]);
                swap8(o0, o1, up);
                bf16_t* rowp = U + (rowb + ai * HALF + m * 16) * 1024 + col0;
                *(u32x4*)rowp = o0; *(u32x4*)(rowp + (size_t)8 * 1024) = o1;
            }
    }
};

struct EpiOut {
    static constexpr bool PERM = true, AFTER_DRAIN = false;
    const float* xp; const float* xs; float* out; int MP;
    struct Pre {}; __device__ __forceinline__ void preload(Pre&, const Unit&, int, int, int, int) const {}
    __device__ __forceinline__ void operator()(const f32x4 (&acc)[2][2][4][2], const Unit& u, int wr, int wc, int fr, int fq, const Pre&) const {
        const bool up = (fr & 8) != 0;
        const int col0 = u.pn * BM + wc * 64 + 8 * fq + (up ? 4 : 0); const int r0 = u.pm * BM;
        const float* __restrict__ xb = ((r0 < MP) ? xp + (size_t)r0 * 1024 : xs + (size_t)(r0 - MP) * 1024) + (size_t)(wr * 64 + (fr & 7)) * 1024 + col0;
        float* __restrict__ ob = out + (size_t)r0 * 1024 + (size_t)(wr * 64 + (fr & 7)) * 1024 + col0;
        f32x4 xv[8][2][2];
#define EO_LOAD(g) do { _Pragma("unroll") for (int bj = 0; bj < 2; ++bj) _Pragma("unroll") for (int h = 0; h < 2; ++h) \
            xv[g][bj][h] = *(const f32x4*)(xb + (size_t)(((g) >> 2) * HALF + ((g) & 3) * 16 + 8 * h) * 1024 + 32 * bj); } while (0)
        EO_LOAD(0); EO_LOAD(1); EO_LOAD(2);
#pragma unroll
        for (int g = 0; g < 8; ++g) {
            if (g + 3 < 8) EO_LOAD(g + 3);
#pragma unroll
            for (int bj = 0; bj < 2; ++bj) { f32x4 a = acc[g >> 2][bj][g & 3][0], b = acc[g >> 2][bj][g & 3][1]; swap8f(a, b, up);
                *(f32x4*)(ob + (size_t)((g >> 2) * HALF + (g & 3) * 16) * 1024 + 32 * bj) = xv[g][bj][0] + a;
                *(f32x4*)(ob + (size_t)((g >> 2) * HALF + (g & 3) * 16 + 8) * 1024 + 32 * bj) = xv[g][bj][1] + b; }
        }
#undef EO_LOAD
    }
};

template <class Epi, class Sched, bool ALIGN_EPI = false, bool SP2 = false, bool I8 = false>
__device__ __forceinline__ void gemm_phase(PG8_LAS unsigned char* lds, const Gemm g, const Sched& S, const Epi& E) {
    const int tid = threadIdx.x, wid = __builtin_amdgcn_readfirstlane(tid >> 6), lane = tid & 63, wr = wid >> 2, wc = wid & 3, fr = lane & 15, fq = lane >> 4;
    const int K = g.K, nt = K / BK;
    unsigned voffA[2], voffB[2];
#pragma unroll
    for (int i = 0; i < 2; ++i) { int R, C; stage_rc(tid * 16 + i * 8192, R, C); const int Rb = Epi::PERM ? ((R & ~31) + perm32(R & 31)) : R;
        voffA[i] = (unsigned)(R * g.lda + C) * 2u; voffB[i] = (unsigned)(Rb * g.ldb + C) * 2u; }
    const size_t kstep = (size_t)(BK * 2);
    const size_t hstepA = (size_t)HALF * g.lda * 2, hstepB = (size_t)HALF * g.ldb * 2;
    const size_t tstepA = 2 * hstepA, tstepB = 2 * hstepB;
    const unsigned ldsw = (unsigned)wid * 1024u;
    const int aoff = lds_byte(wr * 64 + fr, fq * 8), boff = lds_byte(wc * 32 + fr, fq * 8);
#define PG8_SA(b, h) (((b) * 2 + (h)) * HTB)
#define PG8_SB(b, h) ((4 + (b) * 2 + (h)) * HTB)
#define PG8_STAGE(bufoff, gbase, voff) do { _Pragma("unroll") for (int _i = 0; _i < 2; ++_i) \
        __builtin_amdgcn_global_load_lds((const unsigned*)((const char*)(gbase) + (voff)[_i]), (PG8_LAS unsigned*)(lds + (bufoff) + ldsw + _i * 8192), 16, 0, 0); } while (0)
#define PG8_LDA(dst, b, h) do { _Pragma("unroll") for (int m = 0; m < 4; ++m) _Pragma("unroll") for (int k = 0; k < 2; ++k) dst[m][k] = *(const PG8_LAS bf16x8*)(lds + PG8_SA(b, h) + aoff + m * 2048 + k * 1024); } while (0)
#define PG8_LDB(dst, b, h) do { _Pragma("unroll") for (int n = 0; n < 2; ++n) _Pragma("unroll") for (int k = 0; k < 2; ++k) dst[n][k] = *(const PG8_LAS bf16x8*)(lds + PG8_SB(b, h) + boff + n * 2048 + k * 1024); } while (0)
#define PG8_MMA(ai, bj, At, Bt) do { __builtin_amdgcn_s_setprio(1); _Pragma("unroll") for (int m = 0; m < 4; ++m) _Pragma("unroll") for (int n = 0; n < 2; ++n) _Pragma("unroll") for (int k = 0; k < 2; ++k) \
        { if constexpr (I8) acc[ai][bj][m][n] = __builtin_bit_cast(f32x4, __builtin_amdgcn_mfma_i32_16x16x64_i8(__builtin_bit_cast(i32x4, Bt[n][k]), __builtin_bit_cast(i32x4, At[m][k]), __builtin_bit_cast(i32x4, acc[ai][bj][m][n]), 0, 0, 0)); \
          else acc[ai][bj][m][n] = __builtin_amdgcn_mfma_f32_16x16x32_bf16(Bt[n][k], At[m][k], acc[ai][bj][m][n], 0, 0, 0); } __builtin_amdgcn_s_setprio(0); } while (0)
#define PG8_WAIT_V(n) asm volatile("s_waitcnt vmcnt(" #n ")" ::: "memory")
#define PG8_WAIT_L(n) asm volatile("s_waitcnt lgkmcnt(" #n ")" ::: "memory")
#define PG8_BAR __builtin_amdgcn_s_barrier()
#define PG8_SCHED __builtin_amdgcn_sched_barrier(0)
    Unit cur, nxt; int ui = 0;
    if (!S.next(0, cur)) return;
    typename Epi::Pre pre;
    f32x4 acc[2][2][4][2];
#pragma unroll
    for (int a = 0; a < 2; ++a)
#pragma unroll
        for (int b = 0; b < 2; ++b)
#pragma unroll
            for (int m = 0; m < 4; ++m)
#pragma unroll
                for (int n = 0; n < 2; ++n) acc[a][b][m][n] = (f32x4){0.f, 0.f, 0.f, 0.f};
    bf16x8 At[4][2], B0[2][2], B1[2][2];
    const size_t khstep = (size_t)K * 2;
    const char* cA = (const char*)g.A + (size_t)cur.pm * tstepA + cur.kh * khstep; const char* cB = (const char*)g.Bt + (size_t)cur.pn * tstepB + cur.kh * khstep;
    S.a_ready(cur);
    if constexpr (SP2) {
        PG8_STAGE(PG8_SB(0, 0), cB, voffB); PG8_STAGE(PG8_SB(0, 1), cB + hstepB, voffB); PG8_STAGE(PG8_SA(0, 0), cA, voffA); PG8_STAGE(PG8_SA(0, 1), cA + hstepA, voffA);
        if (wr == 1) PG8_BAR;
        PG8_WAIT_V(2); PG8_BAR;
        PG8_STAGE(PG8_SB(1, 0), cB + kstep, voffB); PG8_STAGE(PG8_SA(1, 0), cA + kstep, voffA); PG8_STAGE(PG8_SB(1, 1), cB + hstepB + kstep, voffB);
        PG8_WAIT_V(6); PG8_BAR;
    } else {
        PG8_STAGE(PG8_SB(0, 0), cB, voffB); PG8_STAGE(PG8_SA(0, 0), cA, voffA); PG8_STAGE(PG8_SB(0, 1), cB + hstepB, voffB); PG8_STAGE(PG8_SA(0, 1), cA + hstepA, voffA);
        if (wr == 1) PG8_BAR;
        PG8_WAIT_V(4); PG8_BAR;
        PG8_STAGE(PG8_SB(1, 0), cB + kstep, voffB); PG8_STAGE(PG8_SA(1, 0), cA + kstep, voffA); PG8_STAGE(PG8_SB(1, 1), cB + hstepB + kstep, voffB);
        PG8_WAIT_V(6); PG8_BAR;
    }
    for (;;) {
        const bool has_next = S.next(ui + 1, nxt);
        const char* nA = has_next ? (const char*)g.A + (size_t)nxt.pm * tstepA + nxt.kh * khstep : cA; const char* nB = has_next ? (const char*)g.Bt + (size_t)nxt.pn * tstepB + nxt.kh * khstep : cB;
        for (int t = 0; t < nt; t += 2) {
            const bool last = (t == nt - 2);
            const char* a1 = cA + (size_t)(t + 1) * kstep;
            const char* a2 = last ? nA : cA + (size_t)(t + 2) * kstep; const char* b2 = last ? nB : cB + (size_t)(t + 2) * kstep;
            const char* a3 = a2 + kstep; const char* b3 = b2 + kstep;
            if (last && has_next) S.a_ready(nxt);
            if (last) E.preload(pre, cur, wr, wc, fr, fq);
            if constexpr (SP2) {
            PG8_LDB(B0, 0, 0); PG8_LDB(B1, 0, 1); PG8_SCHED; PG8_LDA(At, 0, 0); PG8_STAGE(PG8_SA(1, 1), a1 + hstepA, voffA);
            PG8_WAIT_V(8); PG8_WAIT_L(0); PG8_BAR; PG8_MMA(0, 0, At, B0); PG8_MMA(0, 1, At, B1); PG8_BAR; PG8_SCHED;
            PG8_LDA(At, 0, 1); PG8_STAGE(PG8_SB(0, 0), b2, voffB); PG8_STAGE(PG8_SB(0, 1), b2 + hstepB, voffB); PG8_STAGE(PG8_SA(0, 0), a2, voffA);
            PG8_WAIT_V(8); PG8_WAIT_L(0); PG8_BAR; PG8_MMA(1, 0, At, B0); PG8_MMA(1, 1, At, B1); PG8_BAR; PG8_SCHED;
            PG8_LDB(B0, 1, 0); PG8_LDB(B1, 1, 1); PG8_SCHED; PG8_LDA(At, 1, 0); PG8_STAGE(PG8_SA(0, 1), a2 + hstepA, voffA);
            PG8_WAIT_V(8); PG8_WAIT_L(0); PG8_BAR; PG8_MMA(0, 0, At, B0); PG8_MMA(0, 1, At, B1); PG8_BAR; PG8_SCHED;
            PG8_LDA(At, 1, 1); PG8_STAGE(PG8_SB(1, 0), b3, voffB); PG8_STAGE(PG8_SB(1, 1), b3 + hstepB, voffB); PG8_STAGE(PG8_SA(1, 0), a3, voffA);
            PG8_WAIT_V(8); PG8_WAIT_L(0); PG8_BAR; PG8_MMA(1, 0, At, B0); PG8_MMA(1, 1, At, B1); PG8_BAR; PG8_SCHED;
            } else {
            PG8_LDB(B0, 0, 0); PG8_SCHED; PG8_LDA(At, 0, 0); PG8_STAGE(PG8_SA(1, 1), a1 + hstepA, voffA);
            PG8_WAIT_L(8); PG8_BAR; PG8_WAIT_L(0); PG8_MMA(0, 0, At, B0); PG8_BAR; PG8_SCHED;
            PG8_LDB(B1, 0, 1); PG8_STAGE(PG8_SB(0, 0), b2, voffB);
            PG8_BAR; PG8_WAIT_L(0); PG8_MMA(0, 1, At, B1); PG8_BAR;
            PG8_LDA(At, 0, 1); PG8_STAGE(PG8_SA(0, 0), a2, voffA);
            PG8_BAR; PG8_WAIT_L(0); PG8_MMA(1, 0, At, B0); PG8_BAR; PG8_SCHED;
            PG8_STAGE(PG8_SB(0, 1), b2 + hstepB, voffB);
            PG8_WAIT_V(6); PG8_BAR; PG8_MMA(1, 1, At, B1); PG8_BAR;
            PG8_LDB(B0, 1, 0); PG8_SCHED; PG8_LDA(At, 1, 0); PG8_STAGE(PG8_SA(0, 1), a2 + hstepA, voffA);
            PG8_WAIT_L(8); PG8_BAR; PG8_WAIT_L(0); PG8_MMA(0, 0, At, B0); PG8_BAR; PG8_SCHED;
            PG8_LDB(B1, 1, 1); PG8_STAGE(PG8_SB(1, 0), b3, voffB);
            PG8_BAR; PG8_WAIT_L(0); PG8_MMA(0, 1, At, B1); PG8_BAR;
            PG8_LDA(At, 1, 1); PG8_STAGE(PG8_SA(1, 0), a3, voffA);
            PG8_BAR; PG8_WAIT_L(0); PG8_MMA(1, 0, At, B0); PG8_BAR; PG8_SCHED;
            PG8_STAGE(PG8_SB(1, 1), b3 + hstepB, voffB);
            PG8_WAIT_V(6); PG8_BAR; PG8_MMA(1, 1, At, B1); PG8_BAR;
            }
        }
        if constexpr (ALIGN_EPI) { if (wr == 0) PG8_BAR; }
        if constexpr (!Epi::AFTER_DRAIN) { E(acc, cur, wr, wc, fr, fq, pre); S.done(cur); }
        if (!has_next) break;
        if (nxt.kh == 0) {
#pragma unroll
        for (int a = 0; a < 2; ++a)
#pragma unroll
            for (int b = 0; b < 2; ++b)
#pragma unroll
                for (int m = 0; m < 4; ++m)
#pragma unroll
                    for (int n = 0; n < 2; ++n) acc[a][b][m][n] = (f32x4){0.f, 0.f, 0.f, 0.f};
        }
        cur = nxt; cA = nA; cB = nB; ++ui;
        if constexpr (ALIGN_EPI) { if (wr == 1) PG8_BAR; }
    }
    PG8_WAIT_V(0);
    if constexpr (!ALIGN_EPI) { if (wr == 0) PG8_BAR; }
    PG8_BAR;
    if constexpr (Epi::AFTER_DRAIN) { E.fused(acc, cur, wr, wc, fr, fq, lds, wid, lane); S.done(cur); }
#undef PG8_SA
#undef PG8_SB
#undef PG8_STAGE
#undef PG8_LDA
#undef PG8_LDB
#undef PG8_MMA
#undef PG8_WAIT_V
#undef PG8_WAIT_L
#undef PG8_BAR
#undef PG8_SCHED
}
}

constexpr int NWAVES = 8;
constexpr int DM = 1024, DIN = 5376, SEQ_P = 4096, SEQ_S = 8192, NB = 8;
constexpr int MP = NB * SEQ_P, MS = NB * SEQ_S, M = MP + MS;
constexpr size_t MiB = 1u << 20;
constexpr size_t WS_CTL = 0, CTL_ZERO_BYTES = 1 * MiB;
constexpr size_t WS_WIN = 2 * MiB, WS_WO = 13 * MiB, WS_WOUT = 15 * MiB;
constexpr size_t WS_XN = 32 * MiB;
constexpr size_t WS_QA = 224 * MiB, WS_KA = 320 * MiB, WS_VA = 416 * MiB, WS_ZA = 512 * MiB, WS_QB = 608 * MiB, WS_ZB = 704 * MiB, WS_KVB = 800 * MiB;
constexpr size_t WS_MRG = WS_QA;
constexpr size_t WS_XN8 = 848 * MiB, WS_RSC = 944 * MiB, WS_WG8 = 946 * MiB;
constexpr size_t WS_END = 952 * MiB;
constexpr int NBF = 0, NI8 = 5376;
constexpr int CW_CMAX = 8192;
constexpr int CW_BAR = 4096;
constexpr int RING_OFF = 0, RING_BYTES = 131072, LDS_BYTES = 163840, LDSCTL_OFF = LDS_BYTES - 1024, MISC_OFF = LDSCTL_OFF + 320, ATT_LDS_BYTES = LDSCTL_OFF;

#define GAS __attribute__((address_space(1)))
#define LAS __attribute__((address_space(3)))
typedef unsigned short bf16;
typedef unsigned v4u __attribute__((ext_vector_type(4)));
typedef float f32x4 __attribute__((ext_vector_type(4)));
typedef GAS unsigned gu32;
#define LDS_WAIT() asm volatile("s_waitcnt lgkmcnt(0)" ::: "memory")
#define VM_WAIT() asm volatile("s_waitcnt vmcnt(0)" ::: "memory")
__device__ __forceinline__ unsigned f2bf(float f) { unsigned u = __builtin_bit_cast(unsigned, f); return (u + 0x7fffu + ((u >> 16) & 1u)) >> 16; }
__device__ __forceinline__ unsigned pk2(float lo, float hi) { return f2bf(lo) | (f2bf(hi) << 16); }
__device__ __forceinline__ float bf2f(unsigned short b) { return __uint_as_float((unsigned)b << 16); }

#define XB_TMO      128
#define XB_XCNT(j)  (256  + 64 * (j))
#define XB_XSUB(j)  (1280 + 64 * (j))
#define XB_XGEN(j)  (2304 + 64 * (j))
#define XB_TOP      3328
#define XB_TOPGEN   3392
#define XCD_BAR_WORDS 3456
#define XB_SPIN_CAP (1u << 18)

__device__ __forceinline__ unsigned xb_ld(unsigned* p)              { return __hip_atomic_load(p, __ATOMIC_RELAXED, __HIP_MEMORY_SCOPE_AGENT); }
__device__ __forceinline__ unsigned xb_add(unsigned* p, unsigned v) { return __hip_atomic_fetch_add(p, v, __ATOMIC_RELAXED, __HIP_MEMORY_SCOPE_AGENT); }
__device__ __forceinline__ unsigned xb_xcc_id() { return (unsigned)__builtin_amdgcn_s_getreg((3 << 11) | 20) & 0xFu; }
#define XB_SPIN(cond, bar) do { unsigned _sp = 0; while (cond) { __builtin_amdgcn_s_sleep(1); \
    if ((++_sp & 255u) == 0u) { if (xb_ld(&(bar)[XB_TMO])) break; if (_sp > XB_SPIN_CAP) { atomicAdd(&(bar)[XB_TMO], 1u); break; } } } } while (0)

struct XcdBarrier {
    unsigned* bar; unsigned x;
    volatile LAS unsigned* st;
};

__device__ __forceinline__ XcdBarrier xcd_barrier_post(unsigned* bar, volatile LAS unsigned* st) {
    XcdBarrier b; b.bar = bar; b.x = xb_xcc_id(); b.st = st;
    if (threadIdx.x == 0) (void)xb_add(&bar[XB_XCNT(b.x)], 1u);
    return b;
}
__device__ __forceinline__ void xcd_barrier_complete(unsigned* bar, unsigned x, unsigned& nloc, unsigned& nx) {
    const unsigned G = gridDim.x * gridDim.y * gridDim.z;
    unsigned sum, cnt, mine, sp = 0u;
    for (;;) {
        sum = 0u; cnt = 0u; mine = 0u;
#pragma unroll
        for (unsigned j = 0; j < 16; ++j) { const unsigned c = xb_ld(&bar[XB_XCNT(j)]); sum += c; cnt += (c > 0u) ? 1u : 0u; mine = (j == x) ? c : mine; }
        if (sum == G) break;
        __builtin_amdgcn_s_sleep(1);
        if ((++sp & 255u) == 0u) { if (xb_ld(&bar[XB_TMO])) break; if (sp > XB_SPIN_CAP) { atomicAdd(&bar[XB_TMO], 1u); break; } }
    }
    nloc = mine > 0u ? mine : 1u; nx = cnt > 0u ? cnt : 1u;
}

__device__ __forceinline__ void xcd_barrier(const XcdBarrier& b) {
    asm volatile("s_waitcnt vmcnt(0)" ::: "memory");
    __syncthreads();
    if (threadIdx.x == 0) {
        unsigned* bar = b.bar;
        __builtin_amdgcn_s_waitcnt(0);
        unsigned nloc = b.st[0], nx = b.st[1];
        if (nloc == 0u) { xcd_barrier_complete(bar, b.x, nloc, nx); b.st[0] = nloc; b.st[1] = nx; }
        const unsigned old = xb_add(&bar[XB_XSUB(b.x)], 1u);
        const unsigned gen = old / nloc;
        if (old + 1u == (gen + 1u) * nloc) {
            __builtin_amdgcn_fence(__ATOMIC_RELEASE, "agent");
            asm volatile("s_waitcnt vmcnt(0)" ::: "memory");
            const unsigned og = xb_add(&bar[XB_TOP], 1u);
            const unsigned tg = og / nx;
            if (og + 1u == (tg + 1u) * nx) xb_add(&bar[XB_TOPGEN], 1u);
            else XB_SPIN(xb_ld(&bar[XB_TOPGEN]) == tg, bar);
            __builtin_amdgcn_fence(__ATOMIC_ACQUIRE, "agent");
            xb_add(&bar[XB_XGEN(b.x)], 1u);
            asm volatile("s_waitcnt vmcnt(0)" ::: "memory");
        } else {
            XB_SPIN(xb_ld(&bar[XB_XGEN(b.x)]) == gen, bar);
            __builtin_amdgcn_fence(__ATOMIC_ACQUIRE, "agent");
            asm volatile("s_waitcnt vmcnt(0)" ::: "memory");
        }
    }
    __syncthreads();
}


struct Frame {
    LAS unsigned char* lds; volatile LAS unsigned* MISC; gu32* ctl;
    int tid, lane, wave, vcu, G;
    const float *xp, *xs, *norm_g, *w_in, *qn_a, *kn_a, *rpb, *qn_b, *kn_b, *sink, *w_o_a, *w_o_b, *w_out, *t5; float* out;
    bf16 *Win_t, *Wo_t, *Wout_t, *XN, *QA, *KA, *VA, *ZA, *QB, *ZB, *KVB, *MRG; unsigned char *XN8, *WG8; float *RSC, *CS;
};
__device__ __forceinline__ float wave_sum(float v) {
#pragma unroll
    for (int o = 1; o < 64; o <<= 1) v += __shfl_xor(v, o);
    return v;
}
__device__ __forceinline__ float wave_max(float v) {
#pragma unroll
    for (int o = 1; o < 64; o <<= 1) v = fmaxf(v, __shfl_xor(v, o));
    return v;
}
__host__ __device__ __forceinline__ int colperm(int cs) { return (cs & ~255) | (((cs >> 5) & 1) << 7) | (((cs >> 6) & 3) << 5) | (cs & 31); }
__device__ __forceinline__ int src_col_bf(int nb) { const int t = nb >> 3; return (t < 2 ? 256 * t : 2048 + 256 * (t - 2)) + 32 * (nb & 7); }
__device__ __forceinline__ int src_col_i8(int nb) { return 32 * nb; }
template <int MAP> __device__ __forceinline__ int src_col(int c0, int nb) { return MAP == 0 ? c0 + 32 * nb : (MAP == 1 ? src_col_bf(nb) : src_col_i8(nb)); }
template <int MAP>
__device__ __forceinline__ void p0_transpose_item(const float* W, int ldw, int c0, int ncb, bf16* WT, int ldk, int koff, LAS float* scr, int item, int lane) {
    const int kb = item / ncb, nb = item % ncb, k0 = 64 * kb, n0 = 32 * nb; c0 = src_col<MAP>(c0, nb) - n0;
#pragma unroll 8
    for (int i = 0; i < 32; ++i) { const int kk = 2 * i + (lane >> 5); scr[kk * 33 + (lane & 31)] = W[(size_t)(k0 + kk) * ldw + c0 + n0 + (lane & 31)]; }
    LDS_WAIT(); asm volatile("" ::: "memory");
    const int c = lane & 7;
#pragma unroll
    for (int j = 0; j < 4; ++j) { const int n = (lane >> 3) + 8 * j; const LAS float* s = scr + (8 * c) * 33 + n;
        v4u o; o.x = pk2(s[0 * 33], s[1 * 33]); o.y = pk2(s[2 * 33], s[3 * 33]); o.z = pk2(s[4 * 33], s[5 * 33]); o.w = pk2(s[6 * 33], s[7 * 33]);
        *(GAS v4u*)(WT + (size_t)colperm(n0 + n) * ldk + koff + k0 + 8 * c) = o; }
    LDS_WAIT(); asm volatile("" ::: "memory");
}
__device__ __forceinline__ void p0_quant_block(const float* W, int ldw, int nb, unsigned char* W8, float* cs, LAS float* scr, LAS float* red, int wave, int lane) {
    const int n0 = 32 * nb, kw = 128 * wave;
    float mx = 0.f;
#pragma unroll 8
    for (int i = 0; i < 64; ++i) { const int kk = kw + 2 * i + (lane >> 5); mx = fmaxf(mx, fabsf(W[(size_t)kk * ldw + n0 + (lane & 31)])); }
    mx = fmaxf(mx, __shfl_xor(mx, 32));
    if (lane < 32) red[wave * 32 + lane] = mx;
    __syncthreads();
    const int c = lane & 7;
    float cmx[4];
#pragma unroll
    for (int j = 0; j < 4; ++j) { const int n = (lane >> 3) + 8 * j; float m = 0.f;
#pragma unroll
        for (int w = 0; w < NWAVES; ++w) m = fmaxf(m, red[w * 32 + n]);
        cmx[j] = fmaxf(m, 1e-30f); if (wave == 0 && c == 0) cs[n0 + n] = cmx[j] * (1.0f / 127.0f); }
#pragma unroll
    for (int hk = 0; hk < 2; ++hk) {
        const int k0 = kw + 64 * hk;
#pragma unroll 8
        for (int i = 0; i < 32; ++i) { const int kk = 2 * i + (lane >> 5); scr[kk * 33 + (lane & 31)] = W[(size_t)(k0 + kk) * ldw + n0 + (lane & 31)]; }
        LDS_WAIT(); asm volatile("" ::: "memory");
#pragma unroll
        for (int j = 0; j < 4; ++j) { const int n = (lane >> 3) + 8 * j; const LAS float* s = scr + (8 * c) * 33 + n; const float qs = 127.0f / cmx[j];
            unsigned lo = 0u, hi = 0u;
#pragma unroll
            for (int e = 0; e < 4; ++e) { lo |= ((unsigned)(int)rintf(s[e * 33] * qs) & 255u) << (8 * e); hi |= ((unsigned)(int)rintf(s[(4 + e) * 33] * qs) & 255u) << (8 * e); }
            *(GAS unsigned long long*)(W8 + (size_t)colperm(n0 + n) * 1024 + k0 + 8 * c) = (unsigned long long)lo | ((unsigned long long)hi << 32); }
        LDS_WAIT(); asm volatile("" ::: "memory");
    }
    __syncthreads();
}
template <int NR>
__device__ __forceinline__ void rms_rows(const float* const (&xrow)[NR], const float* g, bf16* const (&orow)[NR], unsigned char* const (&o8row)[NR], float* const (&rsc)[NR], int lane) {
    f32x4 v[NR][4];
#pragma unroll
    for (int r = 0; r < NR; ++r) { const GAS f32x4* xr = (const GAS f32x4*)xrow[r] + lane;
#pragma unroll
        for (int j = 0; j < 4; ++j) v[r][j] = __builtin_nontemporal_load(xr + 64 * j); }
    const GAS f32x4* gr = (const GAS f32x4*)g + lane;
    f32x4 gv[4];
#pragma unroll
    for (int j = 0; j < 4; ++j) gv[j] = gr[64 * j];
#pragma unroll
    for (int r = 0; r < NR; ++r) {
        float s = 0.f;
#pragma unroll
        for (int j = 0; j < 4; ++j) s += (v[r][j].x * v[r][j].x + v[r][j].y * v[r][j].y) + (v[r][j].z * v[r][j].z + v[r][j].w * v[r][j].w);
        const float rs = 1.0f / sqrtf(wave_sum(s) * (1.f / DM) + 1e-6f);
        float am = 0.f;
#pragma unroll
        for (int j = 0; j < 4; ++j) { v[r][j] = v[r][j] * rs * gv[j];
            am = fmaxf(fmaxf(am, fmaxf(fabsf(v[r][j].x), fabsf(v[r][j].y))), fmaxf(fabsf(v[r][j].z), fabsf(v[r][j].w)));
            }
        am = fmaxf(wave_max(am), 1e-30f); const float qs = 127.0f / am;
        GAS unsigned* q4 = (GAS unsigned*)o8row[r] + lane;
#pragma unroll
        for (int j = 0; j < 4; ++j) q4[64 * j] = ((unsigned)(int)rintf(v[r][j].x * qs) & 255u) | (((unsigned)(int)rintf(v[r][j].y * qs) & 255u) << 8) | (((unsigned)(int)rintf(v[r][j].z * qs) & 255u) << 16) | (((unsigned)(int)rintf(v[r][j].w * qs) & 255u) << 24);
        if (lane == 0) *rsc[r] = am * (1.0f / 127.0f);
    }
}
__device__ __forceinline__ void p0_prologue(Frame& F) {
    LAS float* scr = (LAS float*)(F.lds + RING_OFF + F.wave * 16384);
    const int gw = F.vcu * NWAVES + F.wave, NGW = F.G * NWAVES;
    constexpr int I_OA = (512 / 64) * (DM / 32), I_OUT = (DM / 64) * (DM / 32);
    constexpr int NITEMS = 2 * I_OA + I_OUT;
    { LAS float* red = (LAS float*)(F.lds + RING_OFF + NWAVES * 16384);
      for (int nb = F.vcu; nb < NI8 / 32; nb += F.G) p0_quant_block(F.w_in, DIN, nb, F.WG8, F.CS, scr, red, F.wave, F.lane); }
    for (int it = gw; it < NITEMS; it += NGW) {
        int r = it;
        if (r < I_OA) { p0_transpose_item<0>(F.w_o_a, DM, 0, DM / 32, F.Wo_t, DM, 0, scr, r, F.lane); continue; } r -= I_OA;
        if (r < I_OA) { p0_transpose_item<0>(F.w_o_b, DM, 0, DM / 32, F.Wo_t, DM, 512, scr, r, F.lane); continue; } r -= I_OA;
        p0_transpose_item<0>(F.w_out, DM, 0, DM / 32, F.Wout_t, DM, 0, scr, r, F.lane);
    }
    static_assert(M % 4 == 0 && MP % 4 == 0, "row quads");
    for (int m4 = gw; m4 < M / 4; m4 += NGW) {
        const float* xr[4]; bf16* orow[4]; unsigned char* o8[4]; float* rsc[4];
#pragma unroll
        for (int r = 0; r < 4; ++r) { const int m = 4 * m4 + r; xr[r] = (m < MP) ? F.xp + (size_t)m * DM : F.xs + (size_t)(m - MP) * DM; orow[r] = F.XN + (size_t)m * DM;
            o8[r] = F.XN8 + (size_t)m * DM; rsc[r] = F.RSC + m; }
        rms_rows<4>(xr, F.norm_g, orow, o8, rsc, F.lane);
    }
}
__device__ __forceinline__ int t5_bucket(int rel) {
    const int n = rel < 0 ? -rel : rel; int b;
    if (n < 8) b = n; else { const int lg = 31 - __clz(n * n); b = 8 + (lg - 6); b = b > 15 ? 15 : b; }
    return b + (rel > 0 ? 16 : 0);
}
__device__ __forceinline__ float dot8(v4u q, v4u k) {
    return (pg8::bf_lo(q.x) * pg8::bf_lo(k.x) + pg8::bf_hi(q.x) * pg8::bf_hi(k.x)) + (pg8::bf_lo(q.y) * pg8::bf_lo(k.y) + pg8::bf_hi(q.y) * pg8::bf_hi(k.y))
         + (pg8::bf_lo(q.z) * pg8::bf_lo(k.z) + pg8::bf_hi(q.z) * pg8::bf_hi(k.z)) + (pg8::bf_lo(q.w) * pg8::bf_lo(k.w) + pg8::bf_hi(q.w) * pg8::bf_hi(k.w));
}
__device__ __forceinline__ void attn_naive_A(Frame& F) {
    const int gw = F.vcu * NWAVES + F.wave, NGW = F.G * NWAVES, lane = F.lane;
    for (int idx = gw; idx < M * 8; idx += NGW) {
        const int m = idx >> 3, h = idx & 7;
        int base, t, rows;
        if (m < MP) { base = m & ~(SEQ_P - 1); t = m & (SEQ_P - 1); rows = SEQ_P / 64; } else { const int mm = m - MP; base = MP + (mm & ~(SEQ_S - 1)); t = mm & (SEQ_S - 1); rows = SEQ_S / 64; }
        const int r = t >> 6, c = t & 63;
        int rs = r - 4; rs = rs < 0 ? 0 : rs; rs = rs > rows - 8 ? rows - 8 : rs;
        int cs = c - 8; cs = cs < 0 ? 0 : cs; cs = cs > 48 ? 48 : cs;
        const GAS v4u* qp = (const GAS v4u*)(F.QA + (size_t)m * 512 + h * 64);
        v4u qv[8];
#pragma unroll
        for (int i = 0; i < 8; ++i) qv[i] = qp[i];
        float s0, s1;
#pragma unroll
        for (int jj = 0; jj < 2; ++jj) {
            const int j = lane + 64 * jj, kr = rs + (j >> 4), kc = cs + (j & 15), tok = base + kr * 64 + kc;
            const GAS v4u* kp = (const GAS v4u*)(F.KA + (size_t)tok * 512 + h * 64);
            float d = 0.f;
#pragma unroll
            for (int i = 0; i < 8; ++i) d += dot8(qv[i], kp[i]);
            d += F.rpb[(h * 15 + (kr - r + 7)) * 31 + (kc - c + 15)] * pg8::LOG2E;
            if (jj == 0) s0 = d; else s1 = d;
        }
        const float mx = wave_max(fmaxf(s0, s1));
        const float p0 = __builtin_amdgcn_exp2f(s0 - mx), p1 = __builtin_amdgcn_exp2f(s1 - mx);
        const float l = wave_sum(p0 + p1);
        float o = 0.f;
        for (int j = 0; j < 128; ++j) {
            const float pj = __shfl(j < 64 ? p0 : p1, j & 63);
            const int kr = rs + (j >> 4), kc = cs + (j & 15), tok = base + kr * 64 + kc;
            o += pj * bf2f(F.VA[(size_t)tok * 512 + h * 64 + lane]);
        }
        const float z = bf2f(F.ZA[(size_t)m * 512 + h * 64 + lane]);
        F.XN[(size_t)m * 1024 + h * 64 + lane] = (bf16)f2bf(o / l * z);
    }
}
__device__ __forceinline__ void attn_naive_B(Frame& F) {
    const int gw = F.vcu * NWAVES + F.wave, NGW = F.G * NWAVES, lane = F.lane;
    for (int idx = gw; idx < M * 8; idx += NGW) {
        const int m = idx >> 3, h = idx & 7, kvh = h >> 2;
        int base, t, L;
        if (m < MP) { base = m & ~(SEQ_P - 1); t = m & (SEQ_P - 1); L = SEQ_P; } else { const int mm = m - MP; base = MP + (mm & ~(SEQ_S - 1)); t = mm & (SEQ_S - 1); L = SEQ_S; }
        const GAS v4u* qp = (const GAS v4u*)(F.QB + (size_t)m * 512 + h * 64);
        v4u qv[8];
#pragma unroll
        for (int i = 0; i < 8; ++i) qv[i] = qp[i];
        float s[5]; float mxl = -INFINITY;
#pragma unroll
        for (int jj = 0; jj < 5; ++jj) {
            const int rel = -128 + lane + 64 * jj, j = t + rel; const bool valid = rel <= 128 && j >= 0 && j < L;
            float d = -INFINITY;
            if (valid) {
                const GAS v4u* kp = (const GAS v4u*)(F.KVB + (size_t)(base + j) * 256 + kvh * 64);
                d = 0.f;
#pragma unroll
                for (int i = 0; i < 8; ++i) d += dot8(qv[i], kp[i]);
                d += F.t5[t5_bucket(rel) * 8 + h] * pg8::LOG2E;
            }
            s[jj] = d; mxl = fmaxf(mxl, d);
        }
        const float sl = F.sink[h] * pg8::LOG2E;
        const float mx = fmaxf(wave_max(mxl), sl);
        float ps = 0.f;
#pragma unroll
        for (int jj = 0; jj < 5; ++jj) { s[jj] = __builtin_amdgcn_exp2f(s[jj] - mx); ps += s[jj]; }
        const float l = wave_sum(ps) + __builtin_amdgcn_exp2f(sl - mx);
        float o = 0.f;
#pragma unroll
        for (int jj = 0; jj < 5; ++jj) {
            for (int jl = 0; jl < 64; ++jl) {
                const int rel = -128 + jl + 64 * jj, j = t + rel;
                if (rel > 128 || j < 0 || j >= L) continue;
                const float pj = __shfl(s[jj], jl);
                o += pj * bf2f(F.KVB[(size_t)(base + j) * 256 + 128 + kvh * 64 + lane]);
            }
        }
        const float z = bf2f(F.ZB[(size_t)m * 512 + h * 64 + lane]);
        F.XN[(size_t)m * 1024 + 512 + h * 64 + lane] = (bf16)f2bf(o / l * z);
    }
}

namespace att {
typedef short bf16x8 __attribute__((ext_vector_type(8)));
typedef short s16x4 __attribute__((ext_vector_type(4)));
typedef float f32x16 __attribute__((ext_vector_type(16)));
typedef float f32x2_t __attribute__((ext_vector_type(2)));
typedef __bf16 bf16x2_t __attribute__((ext_vector_type(2)));
constexpr int KB_BYTES = 8192, DHS = 4160, VB_BYTES = 2 * DHS, BUF_BYTES = KB_BYTES + VB_BYTES;
#ifndef ATT_DPF
#define ATT_DPF 2
#endif
constexpr int DPF = ATT_DPF, NS = 4;
constexpr int L_KV = 0, L_RPB = 66560, L_T5 = L_RPB + 4096, L_ZO = L_T5 + 12288, L_Q = L_ZO + 32768, L_WSF = L_Q + 32768, L_RED = L_WSF + 2048, L_END = L_RED + 512;
static_assert(NS * BUF_BYTES <= L_RPB && L_END <= ATT_LDS_BYTES, "attention LDS map");
__device__ __forceinline__ constexpr int crow(int r, int hi) { return (r & 3) + 8 * (r >> 2) + 4 * hi; }
__device__ __forceinline__ unsigned cvtpk(float lo, float hi) { f32x2_t v = {lo, hi}; bf16x2_t b = __builtin_convertvector(v, bf16x2_t); return __builtin_bit_cast(unsigned, b); }
__device__ __forceinline__ s16x4 vtr(const LAS char* p) { return __builtin_bit_cast(s16x4, __builtin_amdgcn_ds_read_tr16_b64_v4i16((LAS s16x4*)p)); }
__device__ __forceinline__ int clampi(int v, int lo, int hi) { return v < lo ? lo : (v > hi ? hi : v); }

template <bool MASKED>
__device__ __forceinline__ void subtile(const LAS char* kp, const int (&koff)[4], const LAS char* vp, const LAS float* tab, const f32x16& colmask, const bf16x8 (&qr)[4], f32x16 (&o)[2], float& lsum) {
    bf16x8 kf[4];
#pragma unroll
    for (int d0 = 0; d0 < 4; ++d0) kf[d0] = *(const LAS bf16x8*)(kp + koff[d0]);
    f32x16 s;
#pragma unroll
    for (int r = 0; r < 16; ++r) s[r] = tab[crow(r, 0)];
    s16x4 vl[2][2], vh[2][2];
#pragma unroll
    for (int dh = 0; dh < 2; ++dh)
#pragma unroll
        for (int ks = 0; ks < 2; ++ks) { vl[dh][ks] = vtr(vp + dh * DHS + ks * 1024); vh[dh][ks] = vtr(vp + dh * DHS + ks * 1024 + 512); }
    if (MASKED) {
#pragma unroll
        for (int r = 0; r < 16; ++r) s[r] += colmask[r]; }
#pragma unroll
    for (int d0 = 0; d0 < 4; ++d0) s = __builtin_amdgcn_mfma_f32_32x32x16_bf16(kf[d0], qr[d0], s, 0, 0, 0);
    float a0 = 0.f, a1 = 0.f;
#pragma unroll
    for (int r = 0; r < 16; r += 2) { s[r] = __builtin_amdgcn_exp2f(s[r]); s[r + 1] = __builtin_amdgcn_exp2f(s[r + 1]); a0 += s[r]; a1 += s[r + 1]; }
    lsum += a0 + a1;
    v4u pw0, pw1;
    pw0.x = cvtpk(s[0], s[1]); pw0.y = cvtpk(s[2], s[3]); pw0.z = cvtpk(s[4], s[5]); pw0.w = cvtpk(s[6], s[7]);
    pw1.x = cvtpk(s[8], s[9]); pw1.y = cvtpk(s[10], s[11]); pw1.z = cvtpk(s[12], s[13]); pw1.w = cvtpk(s[14], s[15]);
#pragma unroll
    for (int dh = 0; dh < 2; ++dh) {
        const bf16x8 v0 = (bf16x8){vl[dh][0][0], vl[dh][0][1], vl[dh][0][2], vl[dh][0][3], vh[dh][0][0], vh[dh][0][1], vh[dh][0][2], vh[dh][0][3]};
        const bf16x8 v1 = (bf16x8){vl[dh][1][0], vl[dh][1][1], vl[dh][1][2], vl[dh][1][3], vh[dh][1][0], vh[dh][1][1], vh[dh][1][2], vh[dh][1][3]};
        o[dh] = __builtin_amdgcn_mfma_f32_32x32x16_bf16(__builtin_bit_cast(bf16x8, pw0), v0, o[dh], 0, 0, 0);
        o[dh] = __builtin_amdgcn_mfma_f32_32x32x16_bf16(__builtin_bit_cast(bf16x8, pw1), v1, o[dh], 0, 0, 0);
    }
}

__device__ __forceinline__ void wave_epilogue(LAS char* L, int wave, int lane, f32x16 (&o)[2], float l, bf16* OG, int tok0, int tok1, int ocol) {
    const int r32 = lane & 31, hi = lane >> 5;
    LAS float* wsf = (LAS float*)(L + L_WSF) + wave * 64;
    LAS bf16* stg = (LAS bf16*)(L + L_ZO) + wave * 2048;
    if (hi == 0) wsf[r32] = __builtin_amdgcn_rcpf(l);
    LDS_WAIT();
#pragma unroll
    for (int r = 0; r < 16; ++r) { const int orow = crow(r, 0) + 4 * hi; const float rl = wsf[orow];
#pragma unroll
        for (int dh = 0; dh < 2; ++dh) { const int idx = orow * 64 + dh * 32 + r32; const float z = bf2f(stg[idx]); stg[idx] = (bf16)f2bf(o[dh][r] * rl * z * pg8::sigmoidf_(z)); } }
    LDS_WAIT();
#pragma unroll
    for (int i = 0; i < 4; ++i) { const int row = i * 8 + (lane >> 3), ch = lane & 7; const int tok = (row < 16 ? tok0 : tok1 - 16) + row;
        const v4u v = *(const LAS v4u*)(stg + row * 64 + ch * 8);
        *(GAS v4u*)(OG + (size_t)tok * 1024 + ocol + ch * 8) = v; }
    LDS_WAIT();
}

__device__ __forceinline__ void setup(Frame& F, LAS char* L) {
    const int tid = F.tid; LAS float* red = (LAS float*)(L + L_RED);
    float mx[6] = {0.f, 0.f, 0.f, 0.f, 0.f, 0.f};
    if (tid < 64) { mx[0] = fabsf(F.qn_a[tid]); mx[1] = fabsf(F.kn_a[tid]); mx[2] = fabsf(F.qn_b[tid]); mx[3] = fabsf(F.kn_b[tid]); }
    for (int i = tid; i < 8 * 15 * 31; i += NWAVES * 64) mx[4] = fmaxf(mx[4], fabsf(F.rpb[i]));
    if (tid < 256) mx[5] = fabsf(F.t5[tid]);
    if (tid < 8) mx[5] = fmaxf(mx[5], fabsf(F.sink[tid]));
#pragma unroll
    for (int k = 0; k < 6; ++k) { const float v = wave_max(mx[k]); if (F.lane == 0) red[F.wave * 6 + k] = v; }
    __syncthreads();
#pragma unroll
    for (int k = 0; k < 6; ++k) { float v = 0.f;
#pragma unroll
        for (int w = 0; w < NWAVES; ++w) v = fmaxf(v, red[w * 6 + k]); mx[k] = v; }
    const float M0a = pg8::C2 * 64.f * mx[0] * mx[1] + pg8::LOG2E * mx[4], M0b = pg8::C2 * 64.f * mx[2] * mx[3] + pg8::LOG2E * mx[5];
    LAS float* t5L = (LAS float*)(L + L_T5);
    for (int i = tid; i < 8 * 384; i += NWAVES * 64) { const int h = i / 384, rel = (i % 384) - 192; const int n = rel < 0 ? -rel : rel;
        t5L[i] = (n <= 128) ? F.t5[t5_bucket(rel) * 8 + h] * pg8::LOG2E - M0b : -INFINITY; }
    __syncthreads();
    if (tid == 0) { red[48] = M0b; red[49] = M0a; }
    __syncthreads();
}

__device__ __forceinline__ void glds16(const void* gsrc, unsigned lds_dst) { unsigned keep;
    asm volatile("s_mov_b32 %0, m0\n\ts_mov_b32 m0, %2\n\ts_nop 0\n\tglobal_load_lds_dwordx4 %1, off\n\ts_mov_b32 m0, %0" : "=&s"(keep) : "v"(gsrc), "s"(lds_dst) : "memory"); }
#define ATT_WAIT_BAR(N) asm volatile("s_waitcnt vmcnt(" #N ") lgkmcnt(0)\n\ts_barrier" ::: "memory")
#define ATT_WB_CASE(N) case N: ATT_WAIT_BAR(N); break;
__device__ __forceinline__ void wait_bar(int n) {
    switch (n < 0 ? 0 : (n > 20 ? 20 : n)) { ATT_WB_CASE(0) ATT_WB_CASE(1) ATT_WB_CASE(2) ATT_WB_CASE(3) ATT_WB_CASE(4) ATT_WB_CASE(5) ATT_WB_CASE(6) ATT_WB_CASE(7) ATT_WB_CASE(8) ATT_WB_CASE(9) ATT_WB_CASE(10)
        ATT_WB_CASE(11) ATT_WB_CASE(12) ATT_WB_CASE(13) ATT_WB_CASE(14) ATT_WB_CASE(15) ATT_WB_CASE(16) ATT_WB_CASE(17) ATT_WB_CASE(18) ATT_WB_CASE(19) default: ATT_WAIT_BAR(20); break; } }
#define ATT_WV_CASE(N) case N: asm volatile("s_waitcnt vmcnt(" #N ")" ::: "memory"); break;
__device__ __forceinline__ void wait_vm(int n) {
    switch (n < 0 ? 0 : (n > 20 ? 20 : n)) { ATT_WV_CASE(0) ATT_WV_CASE(1) ATT_WV_CASE(2) ATT_WV_CASE(3) ATT_WV_CASE(4) ATT_WV_CASE(5) ATT_WV_CASE(6) ATT_WV_CASE(7) ATT_WV_CASE(8) ATT_WV_CASE(9) ATT_WV_CASE(10)
        ATT_WV_CASE(11) ATT_WV_CASE(12) ATT_WV_CASE(13) ATT_WV_CASE(14) ATT_WV_CASE(15) ATT_WV_CASE(16) ATT_WV_CASE(17) ATT_WV_CASE(18) ATT_WV_CASE(19) default: asm volatile("s_waitcnt vmcnt(20)" ::: "memory"); break; } }
struct VmBook {
    int since_pair, since_z, since_q;
    __device__ __forceinline__ void init() { since_pair = since_z = since_q = 1 << 20; }
    __device__ __forceinline__ void issued(int n) { since_pair += n; since_z += n; since_q += n; }
};
__device__ __forceinline__ void dma_rows32(const bf16* p_lane, size_t pitch8, unsigned dst) {
#pragma unroll
    for (int i = 0; i < 4; ++i) glds16(p_lane + i * pitch8, (unsigned)__builtin_amdgcn_readfirstlane(dst + i * 1024));
}

__device__ __forceinline__ void decodeA(int ui, int& h, int& rows, int& base, int& r0) {
    int seq, rg;
    if (ui < 1024) { seq = ui >> 7; h = (ui >> 4) & 7; rg = ui & 15; rows = SEQ_P / 64; base = seq * SEQ_P; }
    else { const int u2 = ui - 1024; seq = u2 >> 8; h = (u2 >> 5) & 7; rg = u2 & 31; rows = SEQ_S / 64; base = MP + seq * SEQ_S; }
    r0 = 4 * rg;
}
__device__ __forceinline__ void build_rpb(Frame& F, LAS char* L, int h) {
    LAS float* rpbL = (LAS float*)(L + L_RPB); const float M0a = ((const LAS float*)(L + L_RED))[49];
    for (int i = F.tid; i < 16 * 64; i += NWAVES * 64) { const int row = i >> 6, col = i & 63;
        float v = 0.f; if (row == 15) v = -INFINITY; else if (col >= 16 && col <= 46) v = F.rpb[(h * 15 + row) * 31 + (col - 16)] * pg8::LOG2E - M0a;
        rpbL[i] = v; }
}
__device__ __forceinline__ int rotA(int a, int T) { const int r0 = ((a + 11) / 12) * 12; return (r0 < a + T) ? r0 - a : 0; }
__device__ __forceinline__ int rowA(int a, int T, int k0, int p) { return (p < T - k0) ? a + k0 + p : a + p - (T - k0); }
struct CursorA {
    int u, t, T, k0; const bf16* pk; const bf16* pv;
    __device__ __forceinline__ void load_unit(const Frame& F, int klo, int vlo) {
        int h, rows, base, r0; decodeA(u, h, rows, base, r0);
        const int rs_lo = clampi(r0 - 4, 0, rows - 8), rs_hi = clampi(r0 - 1, 0, rows - 8) + 8; T = rs_hi - rs_lo; t = 0; k0 = rotA(rs_lo, T);
        const size_t tok = (size_t)(base + rs_lo * 64);
        pk = F.KA + tok * 512 + h * 64 + klo; pv = F.VA + tok * 512 + h * 64 + vlo;
    }
};
#define ATT_DMA(cur, slot) do { const unsigned so_ = (unsigned)(slot) * BUF_BYTES; glds16((cur).pk, (unsigned)__builtin_amdgcn_readfirstlane(kdst + so_)); glds16((cur).pv, (unsigned)__builtin_amdgcn_readfirstlane(vdst + so_)); } while (0)
#define ATT_QFRAGS() do { _Pragma("unroll") for (int d0 = 0; d0 < 4; ++d0) qr[d0] = *(const LAS bf16x8*)(L + L_Q + w * 4096 + r32 * 128 + (2 * d0 + hi) * 16); } while (0)

template <bool DO_COMPUTE = true, bool DO_EPI = true>
__device__ __forceinline__ void phase_A(Frame& F, LAS char* L) {
    const int lane = F.lane, w = F.wave, r32 = lane & 31, hi = lane >> 5;
    const int rp = w >> 2, cb = w & 3, c0 = 16 * cb, cw = (cb == 0) ? 0 : (cb == 1) ? 8 : (cb == 2) ? 24 : 32;
    const int c = c0 + (r32 & 15);
    const int lo = clampi(c - 8, 0, 48) - cw;
    f32x16 colmask;
#pragma unroll
    for (int r = 0; r < 16; ++r) colmask[r] = ((unsigned)(crow(r, 0) + 4 * hi - lo) < 16u) ? 0.f : -INFINITY;
    int koff[4];
    { const int row = cw + r32;
#pragma unroll
      for (int d0 = 0; d0 < 4; ++d0) koff[d0] = row * 128 + (((2 * d0 + hi) ^ ((row >> 1) & 7)) << 4); }
    const int voff = KB_BYTES + (cw + 4 * hi + ((lane & 15) >> 2)) * 64 + ((lane >> 4) & 1) * 32 + (lane & 3) * 8;
    const int krow = 8 * w + (lane >> 3), klo = krow * 512 + (((lane & 7) ^ ((krow >> 1) & 7)) << 3);
    const int vlo = (16 * (w & 3) + (lane >> 2)) * 512 + (w >> 2) * 32 + (lane & 3) * 8;
    const unsigned lds0 = (unsigned)(uintptr_t)L;
    const unsigned kdst = lds0 + L_KV + w * 1024, vdst = lds0 + L_KV + KB_BYTES + (w >> 2) * DHS + (w & 3) * 1024;
    const unsigned qdst = lds0 + L_Q + w * 4096, zdst = lds0 + L_ZO + w * 4096;
    const int qz_lane = (lane >> 3) * 512 + (lane & 7) * 8;
    const LAS float* rpbL = (const LAS float*)(L + L_RPB);
    const int NU = 3072;
    CursorA cur; cur.u = F.vcu; cur.load_unit(F, klo, vlo);
    int cur_h; { int rows_, base_, r0_; decodeA(F.vcu, cur_h, rows_, base_, r0_); }
    build_rpb(F, L, cur_h);
#define ATT_A_PIECE(P, uu, dst, i) do { int h_, rows_, base_, r0_; decodeA((uu), h_, rows_, base_, r0_); \
        glds16((P) + (size_t)(base_ + (r0_ + 2 * rp) * 64 + c0 + ((i) >> 1) * 64 + ((i) & 1) * 8) * 512 + h_ * 64 + qz_lane, (unsigned)__builtin_amdgcn_readfirstlane((dst) + (i) * 1024)); } while (0)
    VmBook vb; vb.init();
#pragma unroll
    for (int i = 0; i < 4; ++i) ATT_A_PIECE(F.QA, F.vcu, qdst, i);
    vb.issued(4); vb.since_q = 0;
    bool more = true; int wslot = 0, rslot = 0;
#define ATT_ISSUE_TILE() do { { const size_t ro_ = (size_t)(rowA(0, cur.T, cur.k0, cur.t)) * (64 * 512); const unsigned so_ = (unsigned)wslot * BUF_BYTES; \
            glds16(cur.pk + ro_, (unsigned)__builtin_amdgcn_readfirstlane(kdst + so_)); glds16(cur.pv + ro_, (unsigned)__builtin_amdgcn_readfirstlane(vdst + so_)); } \
        wslot = (wslot + 1) & (NS - 1); vb.issued(2); vb.since_pair = 0; \
        if (cur.t + 1 < cur.T) { ++cur.t; } else if (cur.u + F.G < NU) { cur.u += F.G; cur.load_unit(F, klo, vlo); } else { more = false; } } while (0)
    { const int np0 = (cur.T - cur.t >= 2) ? 2 : 1; ATT_ISSUE_TILE(); if (np0 == 2) ATT_ISSUE_TILE(); }
    for (int ui = F.vcu; ui < NU; ui += F.G) {
        int h, rows, base, r0; decodeA(ui, h, rows, base, r0);
        const int rs_lo = clampi(r0 - 4, 0, rows - 8), rs_hi = clampi(r0 - 1, 0, rows - 8) + 8, T = rs_hi - rs_lo;
        const int rA = r0 + 2 * rp, r = rA + (r32 >> 4);
        const int rs_r = clampi(r - 4, 0, rows - 8), k0 = rotA(rs_lo, T);
        const int rs_w0 = clampi(rA - 4, 0, rows - 8), rs_w1 = clampi(rA - 3, 0, rows - 8) + 8;
        if (h != cur_h) { ATT_WAIT_BAR(0); build_rpb(F, L, h); cur_h = h; ATT_WAIT_BAR(0); }
        f32x16 o[2]; o[0] = f32x16{}; o[1] = f32x16{}; float lsum = 0.f;
        bf16x8 qr[4];
        const int un = (ui + F.G < NU) ? ui + F.G : ui;
        int ss = 0;
        for (int t = 0; t < T; ++ss) {
            const int n = (T - t >= 2) ? 2 : 1;
            { int w_ = vb.since_pair; if (ss == 0 && vb.since_q < w_) w_ = vb.since_q; wait_bar(w_); }
            if (ss == 0) ATT_QFRAGS();
            const int np = more ? ((cur.T - cur.t >= 2) ? 2 : 1) : 0;
            if (np >= 1) ATT_ISSUE_TILE();
#pragma unroll
            for (int i = 0; i < 2; ++i) if (i < n) {
                const LAS char* buf = L + L_KV + ((rslot + i) & (NS - 1)) * BUF_BYTES;
                const int kr = rowA(rs_lo, T, k0, t + i);
                const bool valid = kr >= rs_r && kr < rs_r + 8; const int trow = valid ? kr - r + 7 : 15;
                const LAS float* tab = rpbL + (trow * 64 + 16 + cw - c + 15 + 4 * hi);
                if (DO_COMPUTE && kr >= rs_w0 && kr < rs_w1) subtile<true>(buf, koff, buf + voff, tab, colmask, qr, o, lsum);
                if (i == 0 && np >= 2) ATT_ISSUE_TILE();
            }
            if (ss == 0) {
#pragma unroll
                for (int i = 0; i < 4; ++i) ATT_A_PIECE(F.ZA, ui, zdst, i);
                vb.issued(4); vb.since_z = 0; }
            if (ss == 1) {
#pragma unroll
                for (int i = 0; i < 4; ++i) ATT_A_PIECE(F.QA, un, qdst, i);
                vb.issued(4); vb.since_q = 0; }
            rslot = (rslot + n) & (NS - 1); t += n;
        }
        { auto rr = __builtin_amdgcn_permlane32_swap(__float_as_uint(lsum), __float_as_uint(lsum), false, false); lsum = __uint_as_float(rr[0]) + __uint_as_float(rr[1]); }
        const int tok0 = base + rA * 64 + c0;
        wait_vm(vb.since_z);
        if (DO_EPI) { wave_epilogue(L, w, lane, o, lsum, F.XN, tok0, tok0 + 64, h * 64); vb.issued(4); }
    }
    ATT_WAIT_BAR(0);
#undef ATT_ISSUE_TILE
#undef ATT_A_PIECE
}

__device__ __forceinline__ void decodeB(int ui, int& kvh, int& Ls, int& base, int& p0) {
    int seq, pb;
    if (ui < 1024) { seq = ui >> 7; kvh = (ui >> 6) & 1; pb = ui & 63; Ls = SEQ_P; base = seq * SEQ_P; }
    else { const int u2 = ui - 1024; seq = u2 >> 8; kvh = (u2 >> 7) & 1; pb = u2 & 127; Ls = SEQ_S; base = MP + seq * SEQ_S; }
    p0 = 64 * pb;
}
struct CursorB {
    int u, t, T; const bf16* pk; const bf16* pv;
    __device__ __forceinline__ void load_unit(const Frame& F, int klo, int vlo) {
        int kvh, Ls, base, p0; decodeB(u, kvh, Ls, base, p0);
        int t_lo = 0, t_hi = 5; if (p0 < 128) t_lo = (128 - p0) >> 6; if (p0 + 192 > Ls) t_hi = 5 - ((p0 + 192 - Ls) >> 6);
        t = t_lo; T = t_hi;
        const long tok = (long)base + p0 - 128 + 64 * t_lo;
        pk = F.KVB + tok * 256 + kvh * 64 + klo; pv = F.KVB + tok * 256 + 128 + kvh * 64 + vlo;
    }
    __device__ __forceinline__ void advance(const Frame& F, int klo, int vlo, int NU) {
        if (t + 1 < T) { ++t; pk += 64 * 256; pv += 64 * 256; }
        else if (u + F.G < NU) { u += F.G; load_unit(F, klo, vlo); }
    }
};

__device__ __forceinline__ void phase_B(Frame& F, LAS char* L) {
    const int lane = F.lane, w = F.wave, r32 = lane & 31, hi = lane >> 5;
    const int gq = w >> 1, half = w & 1;
    int koff[4];
#pragma unroll
    for (int d0 = 0; d0 < 4; ++d0) koff[d0] = r32 * 128 + (((2 * d0 + hi) ^ ((r32 >> 1) & 7)) << 4);
    const int voff = KB_BYTES + (4 * hi + ((lane & 15) >> 2)) * 64 + ((lane >> 4) & 1) * 32 + (lane & 3) * 8;
    const int krow = 8 * w + (lane >> 3), klo = krow * 256 + (((lane & 7) ^ ((krow >> 1) & 7)) << 3);
    const int vlo = (16 * (w & 3) + (lane >> 2)) * 256 + (w >> 2) * 32 + (lane & 3) * 8;
    const unsigned lds0 = (unsigned)(uintptr_t)L;
    const unsigned kdst = lds0 + L_KV + w * 1024, vdst = lds0 + L_KV + KB_BYTES + (w >> 2) * DHS + (w & 3) * 1024;
    const unsigned qdst = lds0 + L_Q + w * 4096, zdst = lds0 + L_ZO + w * 4096;
    const int qz_lane = (lane >> 3) * 512 + (lane & 7) * 8;
    const LAS float* t5L = (const LAS float*)(L + L_T5);
    const float M0b = ((const LAS float*)(L + L_RED))[48];
    const float sink_e0 = __builtin_amdgcn_exp2f(F.sink[gq] * pg8::LOG2E - M0b), sink_e1 = __builtin_amdgcn_exp2f(F.sink[4 + gq] * pg8::LOG2E - M0b);
    const f32x16 dummy = f32x16{};
    const int NU = 3072;
    CursorB cur; cur.u = F.vcu; cur.load_unit(F, klo, vlo);
#define ATT_B_PIECE(P, uu, dst, i) do { int kvh_, Ls_, base_, p0_; decodeB((uu), kvh_, Ls_, base_, p0_); \
        glds16((P) + (size_t)(base_ + p0_ + 32 * half + 8 * (i)) * 512 + (kvh_ * 4 + gq) * 64 + qz_lane, (unsigned)__builtin_amdgcn_readfirstlane((dst) + (i) * 1024)); } while (0)
    VmBook vb; vb.init();
#pragma unroll
    for (int i = 0; i < 4; ++i) ATT_B_PIECE(F.QB, F.vcu, qdst, i);
    vb.issued(4); vb.since_q = 0;
    bool more = true; int wslot = 0, rslot = 0;
#define ATT_ISSUE_TILE() do { ATT_DMA(cur, wslot); wslot = (wslot + 1) & (NS - 1); vb.issued(2); vb.since_pair = 0; \
        if (cur.t + 1 < cur.T) { ++cur.t; cur.pk += 64 * 256; cur.pv += 64 * 256; } else if (cur.u + F.G < NU) { cur.u += F.G; cur.load_unit(F, klo, vlo); } else { more = false; } } while (0)
    { const int np0 = (cur.T - cur.t >= 2) ? 2 : 1; ATT_ISSUE_TILE(); if (np0 == 2) ATT_ISSUE_TILE(); }
    for (int ui = F.vcu; ui < NU; ui += F.G) {
        int kvh, Ls, base, p0; decodeB(ui, kvh, Ls, base, p0);
        const int h = kvh * 4 + gq, pq = p0 + 32 * half, qpos = pq + r32;
        int t_lo = 0, t_hi = 5; if (p0 < 128) t_lo = (128 - p0) >> 6; if (p0 + 192 > Ls) t_hi = 5 - ((p0 + 192 - Ls) >> 6);
        f32x16 o[2]; o[0] = f32x16{}; o[1] = f32x16{}; float lsum = 0.f;
        bf16x8 qr[4];
        const int un = (ui + F.G < NU) ? ui + F.G : ui;
        int ss = 0;
        for (int t = t_lo; t < t_hi; ++ss) {
            const int n = (t_hi - t >= 2) ? 2 : 1;
            { int w_ = vb.since_pair; if (ss == 0 && vb.since_q < w_) w_ = vb.since_q; wait_bar(w_); }
            if (ss == 0) ATT_QFRAGS();
            const int np = more ? ((cur.T - cur.t >= 2) ? 2 : 1) : 0;
            if (np >= 1) ATT_ISSUE_TILE();
#pragma unroll
            for (int i = 0; i < 2; ++i) if (i < n) {
                const LAS char* buf = L + L_KV + ((rslot + i) & (NS - 1)) * BUF_BYTES;
                const LAS float* tab0 = t5L + (h * 384 + (p0 - 128 + 64 * (t + i)) - qpos + 192 + 4 * hi);
                const int ks = p0 - 128 + 64 * (t + i);
                if (ks + 31 >= pq - 128) subtile<false>(buf, koff, buf + voff, tab0, dummy, qr, o, lsum);
                if (i == 0 && np >= 2) ATT_ISSUE_TILE();
                if (ks + 32 <= pq + 31 + 128) subtile<false>(buf + 4096, koff, buf + voff + 2048, tab0 + 32, dummy, qr, o, lsum);
                if (i == 0) {
                    if (ss == 0) {
#pragma unroll
                        for (int k = 0; k < 4; ++k) ATT_B_PIECE(F.ZB, ui, zdst, k);
                        vb.issued(4); vb.since_z = 0; }
                    if (ss == 1) {
#pragma unroll
                        for (int k = 0; k < 4; ++k) ATT_B_PIECE(F.QB, un, qdst, k);
                        vb.issued(4); vb.since_q = 0; }
                }
            }
            rslot = (rslot + n) & (NS - 1); t += n;
        }
        { auto rr = __builtin_amdgcn_permlane32_swap(__float_as_uint(lsum), __float_as_uint(lsum), false, false); lsum = __uint_as_float(rr[0]) + __uint_as_float(rr[1]); }
        lsum += kvh ? sink_e1 : sink_e0;
        const int tok0 = base + pq;
        wait_vm(vb.since_z);
        wave_epilogue(L, w, lane, o, lsum, F.XN, tok0, tok0 + 16, 512 + h * 64); vb.issued(4);
    }
    ATT_WAIT_BAR(0);
#undef ATT_ISSUE_TILE
#undef ATT_B_PIECE
}
#undef ATT_DMA
#undef ATT_QFRAGS
}

#ifndef MK_N_LAUNCHES
#define MK_N_LAUNCHES 1
#endif
constexpr int N_PHASES = 5;
constexpr int N_LAUNCHES = MK_N_LAUNCHES;
struct Args { const float* in[14]; float* out; unsigned char* ws; int ph_lo, ph_hi; };
__global__ void __launch_bounds__(NWAVES * 64, 2) enc_fwd(Args args) {
    extern __shared__ __attribute__((aligned(16))) unsigned char lds[];
    Frame F;
    F.lds = (LAS unsigned char*)lds;
    F.MISC = (volatile LAS unsigned*)(F.lds + MISC_OFF);
    F.tid = threadIdx.x; F.lane = F.tid & 63; F.wave = __builtin_amdgcn_readfirstlane(F.tid >> 6);
    F.G = gridDim.x; { const int bx = blockIdx.x; F.vcu = (F.G % 8 == 0) ? (bx % 8) * (F.G / 8) + bx / 8 : bx; }
    unsigned char* ws = args.ws;
    F.ctl = (gu32*)(ws + WS_CTL);
    F.xp = args.in[0]; F.xs = args.in[1]; F.norm_g = args.in[2]; F.w_in = args.in[3]; F.qn_a = args.in[4]; F.kn_a = args.in[5]; F.rpb = args.in[6];
    F.qn_b = args.in[7]; F.kn_b = args.in[8]; F.sink = args.in[9]; F.w_o_a = args.in[10]; F.w_o_b = args.in[11]; F.w_out = args.in[12]; F.t5 = args.in[13];
    F.out = args.out;
    F.Win_t = (bf16*)(ws + WS_WIN); F.Wo_t = (bf16*)(ws + WS_WO); F.Wout_t = (bf16*)(ws + WS_WOUT);
    F.XN = (bf16*)(ws + WS_XN); F.QA = (bf16*)(ws + WS_QA); F.KA = (bf16*)(ws + WS_KA); F.VA = (bf16*)(ws + WS_VA); F.ZA = (bf16*)(ws + WS_ZA);
    F.QB = (bf16*)(ws + WS_QB); F.ZB = (bf16*)(ws + WS_ZB); F.KVB = (bf16*)(ws + WS_KVB); F.MRG = (bf16*)(ws + WS_MRG); F.XN8 = ws + WS_XN8; F.WG8 = ws + WS_WG8; F.RSC = (float*)(ws + WS_RSC); F.CS = (float*)(ws + WS_RSC + 512 * 1024);
    bf16* Gt = (bf16*)args.out;
    for (int u = F.tid; u < (LDS_BYTES - LDSCTL_OFF) / 4; u += NWAVES * 64) ((LAS unsigned*)(F.lds + LDSCTL_OFF))[u] = 0u;
    __syncthreads();
    XcdBarrier bar; bar.bar = (unsigned*)(F.ctl + CW_BAR); bar.x = 0; bar.st = nullptr;
    if (N_LAUNCHES == 1) bar = xcd_barrier_post((unsigned*)(F.ctl + CW_BAR), F.MISC + 8);
    const int lo = args.ph_lo, hi = args.ph_hi;
#define IN(k) (lo <= (k) && (k) < hi)
#define SEAM(k) do { if (IN(k) && IN((k) + 1)) xcd_barrier(bar); } while (0)

    if (IN(0)) { p0_prologue(F); SEAM(0); }
    if (IN(1)) {
        { pg8::Gemm g{(const bf16*)F.XN8, (const bf16*)F.WG8, 512, 512, 512}; pg8::StaticOrder S; S.init(M, NI8, F.G, (int)blockIdx.x);
          LAS float* csL = (LAS float*)(F.lds + RING_BYTES); LAS float* wL = csL + NI8;
          for (int i = F.tid; i < NI8; i += NWAVES * 64) csL[i] = F.CS[i];
          if (F.tid < 256) { const float* wsrc = (F.tid < 64) ? F.qn_a : (F.tid < 128) ? F.kn_a : (F.tid < 192) ? F.qn_b : F.kn_b; wL[F.tid] = wsrc[F.tid & 63]; }
          __syncthreads();
          pg8::EpiProjI8 E{F.QA, F.KA, F.VA, F.ZA, F.QB, F.KVB, F.ZB, (unsigned char*)Gt, wL, F.RSC, csL, wL + 256};
          pg8::gemm_phase<pg8::EpiProjI8, pg8::StaticOrder, true, true, true>(F.lds + RING_OFF, g, S, E); }
        SEAM(1);
    }
    if (IN(2)) {
#if defined(ATT_NAIVE)
        attn_naive_A(F); attn_naive_B(F);
#else
        LAS char* L = (LAS char*)(F.lds + RING_OFF);
        att::setup(F, L); att::phase_A(F, L); att::phase_B(F, L);
#endif
        SEAM(2);
    }
    if (IN(3)) {
        pg8::Gemm g{F.XN, F.Wo_t, DM, DM, 512}; pg8::StaticOrder S; S.init(M, DM, F.G, (int)blockIdx.x, 2);
        pg8::EpiMerge E{F.MRG, (const unsigned char*)Gt};
        pg8::gemm_phase<pg8::EpiMerge, pg8::StaticOrder, true, true>(F.lds + RING_OFF, g, S, E);
        SEAM(3);
    }
    if (IN(4)) {
        pg8::Gemm g{F.MRG, F.Wout_t, DM, DM, DM}; pg8::StaticOrder S; S.init(M, DM, F.G, (int)blockIdx.x);
        pg8::EpiOut E{F.xp, F.xs, F.out, MP};
        pg8::gemm_phase<pg8::EpiOut, pg8::StaticOrder, true, true>(F.lds + RING_OFF, g, S, E);
    }
#undef IN
#undef SEAM
}

extern "C" void kernel_launch(void* const* d_in, const int* in_sizes, int n_in, void* d_out, int out_size, void* d_ws, size_t ws_size, hipStream_t stream) {
    static int grid = 0;
    if (grid == 0) {
        if (n_in != 14 || in_sizes[0] != MP * DM || in_sizes[1] != MS * DM || out_size != M * DM || ws_size < WS_END) {
            fprintf(stderr, "kernel_launch: unexpected shapes: n_in %d in0 %d in1 %d out %d ws %zu (need %zu); nothing launched\n", n_in, n_in > 0 ? in_sizes[0] : -1, n_in > 1 ? in_sizes[1] : -1, out_size, ws_size, (size_t)WS_END); grid = -1; return; }
        int dev = 0, cus = 0, per_cu = 0;
        if (hipGetDevice(&dev) != hipSuccess || hipDeviceGetAttribute(&cus, hipDeviceAttributeMultiprocessorCount, dev) != hipSuccess) { fprintf(stderr, "kernel_launch: device query failed\n"); grid = -1; return; }
        if (hipFuncSetAttribute((const void*)enc_fwd, hipFuncAttributeMaxDynamicSharedMemorySize, LDS_BYTES) != hipSuccess) { fprintf(stderr, "kernel_launch: hipFuncSetAttribute failed\n"); grid = -1; return; }
        if (hipOccupancyMaxActiveBlocksPerMultiprocessor(&per_cu, (const void*)enc_fwd, NWAVES * 64, LDS_BYTES) != hipSuccess || per_cu < 1) {
            fprintf(stderr, "kernel_launch: occupancy query reports %d workgroups per CU; nothing launched\n", per_cu); (void)hipGetLastError(); grid = -1; return; }
        grid = cus;
    }
    if (grid < 0) return;
    if (hipMemsetAsync((char*)d_ws + WS_CTL, 0, CTL_ZERO_BYTES, stream) != hipSuccess) { fprintf(stderr, "kernel_launch: memset failed\n"); return; }
    Args a{};
    for (int i = 0; i < 14; ++i) a.in[i] = (const float*)d_in[i];
    a.out = (float*)d_out; a.ws = (unsigned char*)d_ws;
    if (N_LAUNCHES == 1) {
        a.ph_lo = 0; a.ph_hi = N_PHASES;
        void* kargs[] = {&a};
        hipError_t e = hipLaunchCooperativeKernel((const void*)enc_fwd, dim3(grid), dim3(NWAVES * 64), kargs, LDS_BYTES, stream);
        if (e != hipSuccess) fprintf(stderr, "kernel_launch: cooperative launch failed: %s (grid %d)\n", hipGetErrorString(e), grid);
    } else {
        for (int li = 0; li < N_PHASES; ++li) {
            a.ph_lo = li; a.ph_hi = li + 1;
            hipLaunchKernelGGL(enc_fwd, dim3(grid), dim3(NWAVES * 64), LDS_BYTES, stream, a);
        }
    }
}
```

```cpp
#include <hip/hip_runtime.h>
#include <cstdio>
#include <cstdint>
namespace pg8 {
constexpr int MROWS = 98304;
#define PG8_LAS __attribute__((address_space(3)))
typedef unsigned short bf16_t;
typedef short bf16x8 __attribute__((ext_vector_type(8)));
typedef float f32x4 __attribute__((ext_vector_type(4)));
typedef unsigned u32x4 __attribute__((ext_vector_type(4)));
typedef int i32x4 __attribute__((ext_vector_type(4)));
constexpr int BM = 256, BK = 64, HALF = 128, HTB = HALF * BK * 2  , STAGE_BYTES = 8 * HTB, NXCD = 8, WGM = 8;

__host__ __device__ __forceinline__ int lds_byte(int r, int c) { const int st = (r >> 4) * 2 + (c >> 5), rr = r & 15, cc = c & 31, ob = rr * 64 + cc * 2; return st * 1024 + (ob ^ (((ob >> 9) & 1) << 5)); }
__host__ __device__ __forceinline__ void stage_rc(int b, int& R, int& C) { const int st = b / 1024, sb = b % 1024, swz = sb ^ (((sb >> 9) & 1) << 5); R = (st >> 1) * 16 + swz / 64; C = (st & 1) * 32 + (swz % 64) / 2; }
__host__ __device__ __forceinline__ int perm32(int rho) { const int n = rho >> 4, i = rho & 15; return 8 * (i >> 2) + 4 * n + (i & 3); }

struct Unit { int pm, pn, kh; };
struct Gemm { const bf16_t* A; const bf16_t* Bt; int lda, ldb, K; };

struct StaticOrder {
    int nM, nN, nwg, G, c, ks;
    __host__ __device__ void init(int M, int N, int G_, int c_, int ks_ = 1) { nM = M / BM; nN = N / BM; nwg = nM * nN; G = G_; c = c_; ks = ks_; }
    __host__ __device__ bool next(int i, Unit& u) const {
        const int it = (ks == 2) ? (i >> 1) : i; u.kh = (ks == 2) ? (i & 1) : 0;
        const long L = (long)it * G + c; if (L >= nwg) return false;
        int wgid = (int)L; { const int q = nwg / NXCD, r = nwg % NXCD, xcd = wgid % NXCD, off = wgid / NXCD; wgid = (xcd < r ? xcd * (q + 1) : r * (q + 1) + (xcd - r) * q) + off; }
        const int nig = WGM * nN, gid = wgid / nig, fm = gid * WGM, gsz = (nM - fm) < WGM ? (nM - fm) : WGM;
        u.pm = fm + ((wgid % nig) % gsz); u.pn = (wgid % nig) / gsz; return true;
    }
    __device__ __forceinline__ void a_ready(const Unit&) const {}
    __device__ __forceinline__ void done(const Unit&) const {}
};

__device__ __forceinline__ unsigned cvt_pk_bf16(float lo, float hi) { unsigned r; asm volatile("v_cvt_pk_bf16_f32 %0, %1, %2" : "=v"(r) : "v"(lo), "v"(hi)); return r; }
__device__ __forceinline__ float bf_lo(unsigned w) { return __uint_as_float(w << 16); }
__device__ __forceinline__ float bf_hi(unsigned w) { return __uint_as_float(w & 0xffff0000u); }
__device__ __forceinline__ float sigmoidf_(float v) { return __builtin_amdgcn_rcpf(1.0f + __builtin_amdgcn_exp2f(-1.4426950408889634f * v)); }

constexpr float C2 = 0.125f * 1.4426950408889634f;
constexpr float LOG2E = 1.4426950408889634f;

__device__ __forceinline__ void swap8(u32x4& a, u32x4& b, bool up) {
    const u32x4 send = up ? a : b; u32x4 recv;
#pragma unroll
    for (int k = 0; k < 4; ++k) recv[k] = (unsigned)__builtin_amdgcn_mov_dpp((int)send[k], 0x128, 0xf, 0xf, false);
    const u32x4 first = up ? recv : a, second = up ? b : recv; a = first; b = second;
}
__device__ __forceinline__ void swap8f(f32x4& a, f32x4& b, bool up) { u32x4 x = __builtin_bit_cast(u32x4, a), y = __builtin_bit_cast(u32x4, b); swap8(x, y, up); a = __builtin_bit_cast(f32x4, x); b = __builtin_bit_cast(f32x4, y); }

__device__ __forceinline__ void proj_rows(f32x4 (&v)[2][2], bool norm, float sc, const f32x4 (&wv)[2][2], bf16_t* rowp, size_t ld, bool up) {
    if (norm) {
        float ss = 0.f;
#pragma unroll
        for (int bj = 0; bj < 2; ++bj)
#pragma unroll
            for (int n = 0; n < 2; ++n) { const f32x4 x = v[bj][n]; ss += (x[0] * x[0] + x[1] * x[1]) + (x[2] * x[2] + x[3] * x[3]); }
        ss += __shfl_xor(ss, 16); ss += __shfl_xor(ss, 32);
        const float rs = __builtin_amdgcn_rsqf(ss * (1.0f / 64.0f) + 1e-6f) * sc;
#pragma unroll
        for (int bj = 0; bj < 2; ++bj)
#pragma unroll
            for (int n = 0; n < 2; ++n) v[bj][n] = v[bj][n] * rs * wv[bj][n];
    }
    u32x4 o0, o1;
    o0.x = cvt_pk_bf16(v[0][0][0], v[0][0][1]); o0.y = cvt_pk_bf16(v[0][0][2], v[0][0][3]); o0.z = cvt_pk_bf16(v[0][1][0], v[0][1][1]); o0.w = cvt_pk_bf16(v[0][1][2], v[0][1][3]);
    o1.x = cvt_pk_bf16(v[1][0][0], v[1][0][1]); o1.y = cvt_pk_bf16(v[1][0][2], v[1][0][3]); o1.z = cvt_pk_bf16(v[1][1][0], v[1][1][1]); o1.w = cvt_pk_bf16(v[1][1][2], v[1][1][3]);
    swap8(o0, o1, up);
    __builtin_nontemporal_store(o0, (u32x4*)rowp); __builtin_nontemporal_store(o1, (u32x4*)(rowp + (size_t)8 * ld));
}
struct EpiProjI8 {
    static constexpr bool PERM = true, AFTER_DRAIN = false;
    bf16_t *QA, *KA, *VA, *ZA, *QB, *KVB, *ZB; unsigned char* G8; const PG8_LAS float* wL; const float* rowscale; const PG8_LAS float* csL; PG8_LAS float* rsL;
    struct Pre {};
    __device__ __forceinline__ void preload(Pre&, const Unit& u, int wr, int wc, int fr, int fq) const {
        if (wr == 0 && wc == 0) __builtin_amdgcn_global_load_lds((const unsigned*)(rowscale + u.pm * BM + (fq * 16 + fr) * 4), (PG8_LAS unsigned*)rsL, 16, 0, 0);
    }
    __device__ __forceinline__ static float sum_fq(float x) {
        { auto rr = __builtin_amdgcn_permlane16_swap(__float_as_uint(x), __float_as_uint(x), false, false); x = __uint_as_float(rr[0]) + __uint_as_float(rr[1]); }
        { auto rr = __builtin_amdgcn_permlane32_swap(__float_as_uint(x), __float_as_uint(x), false, false); x = __uint_as_float(rr[0]) + __uint_as_float(rr[1]); }
        return x;
    }
    __device__ __forceinline__ void operator()(const f32x4 (&acc)[2][2][4][2], const Unit& u, int wr, int wc, int fr, int fq, const Pre&) const {
        const int pn = u.pn;
        const bool up = (fr & 8) != 0;
        float rs[8];
#pragma unroll
        for (int g = 0; g < 8; ++g) rs[g] = rsL[(g >> 2) * HALF + wr * 64 + (g & 3) * 16 + fr];
        f32x4 csv[2][2];
#pragma unroll
        for (int bj = 0; bj < 2; ++bj)
#pragma unroll
            for (int n = 0; n < 2; ++n) csv[bj][n] = *(const PG8_LAS f32x4*)(csL + pn * BM + wc * 64 + 32 * bj + 8 * fq + 4 * n);
        if (pn >= 13) {
            unsigned char* gp = G8 + (size_t)(u.pm * 8 + (pn - 13)) * 65536 + (size_t)(((wr * 4 + wc) * 64) + fq * 16 + fr) * 16;
#pragma unroll
            for (int bj = 0; bj < 2; ++bj)
#pragma unroll
                for (int n = 0; n < 2; ++n) csv[bj][n] = csv[bj][n] * -LOG2E;
#pragma unroll
            for (int g = 0; g < 8; ++g) {
                const float rsc = rs[g];
                u32x4 o;
#pragma unroll
                for (int bj = 0; bj < 2; ++bj)
#pragma unroll
                    for (int n = 0; n < 2; ++n) {
                        f32x4 x = __builtin_convertvector(__builtin_bit_cast(i32x4, acc[g >> 2][bj][g & 3][n]), f32x4) * (csv[bj][n] * rsc);
#pragma unroll
                        for (int i = 0; i < 4; ++i) x[i] = __builtin_amdgcn_exp2f(x[i]);
                        x = x + 1.0f;
#pragma unroll
                        for (int i = 0; i < 4; ++i) x[i] = __builtin_amdgcn_rcpf(x[i]);
                        x = x * 255.0f + 0.5f;
                        o[bj * 2 + n] = (unsigned)x[0] | ((unsigned)x[1] << 8) | ((unsigned)x[2] << 16) | ((unsigned)x[3] << 24); }
                __builtin_nontemporal_store(o, (u32x4*)(gp + g * 8192));
            }
            return;
        }
        bf16_t* base; int plane; int w = 64; bool norm = false; float sc = 1.0f;
        if (pn < 2)        { base = QA;  plane = pn * 4 + wc;        norm = true; w = 0; sc = C2; }
        else if (pn < 4)   { base = KA;  plane = (pn - 2) * 4 + wc;  norm = true; w = 64; }
        else if (pn < 6)   { base = VA;  plane = (pn - 4) * 4 + wc; }
        else if (pn < 8)   { base = ZA;  plane = (pn - 6) * 4 + wc; }
        else if (pn < 10)  { base = QB;  plane = (pn - 8) * 4 + wc;  norm = true; w = 128; sc = C2; }
        else if (pn == 10) { base = KVB; plane = wc;                 norm = wc < 2; w = 192; }
        else               { base = ZB;  plane = (pn - 11) * 4 + wc; }
        const int col0 = 8 * fq + (up ? 32 : 0);
        const size_t ldz = 64;
        bf16_t* const p0 = base + ((size_t)plane * MROWS + (size_t)(u.pm * BM + wr * 64 + (fr & 7))) * ldz + col0;
        f32x4 wv[2][2];
#pragma unroll
        for (int bj = 0; bj < 2; ++bj)
#pragma unroll
            for (int n = 0; n < 2; ++n) wv[bj][n] = *(const PG8_LAS f32x4*)(wL + w + 32 * bj + 8 * fq + 4 * n) * sc;
#pragma unroll
        for (int g = 0; g < 8; ++g) {
            const float r = rs[g];
            f32x4 v[2][2];
            if (norm) {
#pragma unroll
                for (int bj = 0; bj < 2; ++bj)
#pragma unroll
                    for (int n = 0; n < 2; ++n) v[bj][n] = __builtin_convertvector(__builtin_bit_cast(i32x4, acc[g >> 2][bj][g & 3][n]), f32x4) * csv[bj][n];
                f32x4 s4 = v[0][0] * v[0][0];
                s4 = __builtin_elementwise_fma(v[0][1], v[0][1], s4); s4 = __builtin_elementwise_fma(v[1][0], v[1][0], s4); s4 = __builtin_elementwise_fma(v[1][1], v[1][1], s4);
                const float ss = sum_fq((s4[0] + s4[1]) + (s4[2] + s4[3]));
                const float f = r * __builtin_amdgcn_rsqf((r * r) * ss * (1.0f / 64.0f) + 1e-6f);
#pragma unroll
                for (int bj = 0; bj < 2; ++bj)
#pragma unroll
                    for (int n = 0; n < 2; ++n) v[bj][n] = v[bj][n] * (wv[bj][n] * f);
            } else {
#pragma unroll
                for (int bj = 0; bj < 2; ++bj)
#pragma unroll
                    for (int n = 0; n < 2; ++n) v[bj][n] = __builtin_convertvector(__builtin_bit_cast(i32x4, acc[g >> 2][bj][g & 3][n]), f32x4) * (csv[bj][n] * r);
            }
            u32x4 o0, o1;
            o0.x = cvt_pk_bf16(v[0][0][0], v[0][0][1]); o0.y = cvt_pk_bf16(v[0][0][2], v[0][0][3]); o0.z = cvt_pk_bf16(v[0][1][0], v[0][1][1]); o0.w = cvt_pk_bf16(v[0][1][2], v[0][1][3]);
            o1.x = cvt_pk_bf16(v[1][0][0], v[1][0][1]); o1.y = cvt_pk_bf16(v[1][0][2], v[1][0][3]); o1.z = cvt_pk_bf16(v[1][1][0], v[1][1][1]); o1.w = cvt_pk_bf16(v[1][1][2], v[1][1][3]);
            swap8(o0, o1, up);
            bf16_t* rowp = p0 + (size_t)((g >> 2) * HALF + (g & 3) * 16) * ldz;
            __builtin_nontemporal_store(o0, (u32x4*)rowp); __builtin_nontemporal_store(o1, (u32x4*)(rowp + 8 * ldz));
        }
    }
};

struct EpiMerge {
    static constexpr bool PERM = true, AFTER_DRAIN = false;
    bf16_t* U; const unsigned char* G8;
    struct Pre {}; __device__ __forceinline__ void preload(Pre&, const Unit&, int, int, int, int) const {}
    __device__ __forceinline__ static f32x4 ub4(unsigned w) { return (f32x4){(float)(w & 255u), (float)((w >> 8) & 255u), (float)((w >> 16) & 255u), (float)(w >> 24)}; }
    __device__ __forceinline__ void mid(f32x4 (&acc)[2][2][4][2], const Unit& u, int wr, int wc, int fr, int fq) const {
        const unsigned char* ga = G8 + (size_t)(u.pm * 8 + u.pn) * 65536 + (size_t)(((wr * 4 + wc) * 64) + fq * 16 + fr) * 16;
        const unsigned char* gb = ga + 4 * 65536;
        u32x4 qa = *(const u32x4*)ga, qb = *(const u32x4*)gb;
#pragma unroll
        for (int c = 0; c < 8; ++c) {
            const u32x4 ca = qa, cb = qb;
            if (c + 1 < 8) { qa = *(const u32x4*)(ga + (c + 1) * 8192); qb = *(const u32x4*)(gb + (c + 1) * 8192); }
#pragma unroll
            for (int bj = 0; bj < 2; ++bj)
#pragma unroll
                for (int n = 0; n < 2; ++n) { const f32x4 a = ub4(ca[bj * 2 + n]); f32x4 b = ub4(cb[bj * 2 + n]);
#pragma unroll
                    for (int i = 0; i < 4; ++i) b[i] = __builtin_amdgcn_rcpf(fmaxf(b[i], 1.0f));
                    acc[c >> 2][bj][c & 3][n] = acc[c >> 2][bj][c & 3][n] * (a * b); }
        }
    }
    __device__ __forceinline__ void operator()(f32x4 (&acc)[2][2][4][2], const Unit& u, int wr, int wc, int fr, int fq, const Pre&) const {
        if (u.kh == 0) { mid(acc, u, wr, wc, fr, fq); return; }
        const unsigned char* gb = G8 + (size_t)(u.pm * 8 + 4 + u.pn) * 65536 + (size_t)(((wr * 4 + wc) * 64) + fq * 16 + fr) * 16;
        const bool up = (fr & 8) != 0;
        const int col0 = u.pn * BM + wc * 64 + 8 * fq + (up ? 32 : 0);
        const size_t rowb = (size_t)(u.pm * BM + wr * 64 + (fr & 7));
        u32x4 qb[8];
#pragma unroll
        for (int c = 0; c < 8; ++c) qb[c] = *(const u32x4*)(gb + c * 8192);
#pragma unroll
        for (int ai = 0; ai < 2; ++ai)
#pragma unroll
            for (int m = 0; m < 4; ++m) {
                f32x4 v[2][2];
#pragma unroll
                for (int bj = 0; bj < 2; ++bj)
#pragma unroll
                    for (int n = 0; n < 2; ++n) v[bj][n] = acc[ai][bj][m][n] * (__builtin_elementwise_max(ub4(qb[ai * 4 + m][bj * 2 + n]), (f32x4){1.f, 1.f, 1.f, 1.f}) * (1.0f / 255.0f));
                u32x4 o0, o1;
                o0.x = cvt_pk_bf16(v[0][0][0], v[0][0][1]); o0.y = cvt_pk_bf16(v[0][0][2], v[0][0][3]); o0.z = cvt_pk_bf16(v[0][1][0], v[0][1][1]); o0.w = cvt_pk_bf16(v[0][1][2], v[0][1][3]);
                o1.x = cvt_pk_bf16(v[1][0][0], v[1][0][1]); o1.y = cvt_pk_bf16(v[1][0][2], v[1][0][3]); o1.z = cvt_pk_bf16(v[1][1][0], v[1][1][1]); o1.w = cvt_pk_bf16(v[1][1][2], v[1][1][3]);
                swap8(o0, o1, up);
                bf16_t* rowp = U + (rowb + ai * HALF + m * 16) * 1024 + col0;
                *(u32x4*)rowp = o0; *(u32x4*)(rowp + (size_t)8 * 1024) = o1;
            }
    }
};

struct EpiOut {
    static constexpr bool PERM = true, AFTER_DRAIN = false;
    const float* xp; const float* xs; float* out; int MP;
    struct Pre {}; __device__ __forceinline__ void preload(Pre&, const Unit&, int, int, int, int) const {}
    __device__ __forceinline__ void operator()(const f32x4 (&acc)[2][2][4][2], const Unit& u, int wr, int wc, int fr, int fq, const Pre&) const {
        const bool up = (fr & 8) != 0;
        const int col0 = u.pn * BM + wc * 64 + 8 * fq + (up ? 4 : 0); const int r0 = u.pm * BM;
        const float* __restrict__ xb = ((r0 < MP) ? xp + (size_t)r0 * 1024 : xs + (size_t)(r0 - MP) * 1024) + (size_t)(wr * 64 + (fr & 7)) * 1024 + col0;
        float* __restrict__ ob = out + (size_t)r0 * 1024 + (size_t)(wr * 64 + (fr & 7)) * 1024 + col0;
        f32x4 xv[8][2][2];
#define EO_LOAD(g) do { _Pragma("unroll") for (int bj = 0; bj < 2; ++bj) _Pragma("unroll") for (int h = 0; h < 2; ++h) \
            xv[g][bj][h] = *(const f32x4*)(xb + (size_t)(((g) >> 2) * HALF + ((g) & 3) * 16 + 8 * h) * 1024 + 32 * bj); } while (0)
        EO_LOAD(0); EO_LOAD(1); EO_LOAD(2);
#pragma unroll
        for (int g = 0; g < 8; ++g) {
            if (g + 3 < 8) EO_LOAD(g + 3);
#pragma unroll
            for (int bj = 0; bj < 2; ++bj) { f32x4 a = acc[g >> 2][bj][g & 3][0], b = acc[g >> 2][bj][g & 3][1]; swap8f(a, b, up);
                *(f32x4*)(ob + (size_t)((g >> 2) * HALF + (g & 3) * 16) * 1024 + 32 * bj) = xv[g][bj][0] + a;
                *(f32x4*)(ob + (size_t)((g >> 2) * HALF + (g & 3) * 16 + 8) * 1024 + 32 * bj) = xv[g][bj][1] + b; }
        }
#undef EO_LOAD
    }
};

template <class Epi, class Sched, bool ALIGN_EPI = false, bool SP2 = false, bool I8 = false>
__device__ __forceinline__ void gemm_phase(PG8_LAS unsigned char* lds, const Gemm g, const Sched& S, const Epi& E) {
    const int tid = threadIdx.x, wid = __builtin_amdgcn_readfirstlane(tid >> 6), lane = tid & 63, wr = wid >> 2, wc = wid & 3, fr = lane & 15, fq = lane >> 4;
    const int K = g.K, nt = K / BK;
    unsigned voffA[2], voffB[2];
#pragma unroll
    for (int i = 0; i < 2; ++i) { int R, C; stage_rc(tid * 16 + i * 8192, R, C); const int Rb = Epi::PERM ? ((R & ~31) + perm32(R & 31)) : R;
        voffA[i] = (unsigned)(R * g.lda + C) * 2u; voffB[i] = (unsigned)(Rb * g.ldb + C) * 2u; }
    const size_t kstep = (size_t)(BK * 2);
    const size_t hstepA = (size_t)HALF * g.lda * 2, hstepB = (size_t)HALF * g.ldb * 2;
    const size_t tstepA = 2 * hstepA, tstepB = 2 * hstepB;
    const unsigned ldsw = (unsigned)wid * 1024u;
    const int aoff = lds_byte(wr * 64 + fr, fq * 8), boff = lds_byte(wc * 32 + fr, fq * 8);
#define PG8_SA(b, h) (((b) * 2 + (h)) * HTB)
#define PG8_SB(b, h) ((4 + (b) * 2 + (h)) * HTB)
#define PG8_STAGE(bufoff, gbase, voff) do { _Pragma("unroll") for (int _i = 0; _i < 2; ++_i) \
        __builtin_amdgcn_global_load_lds((const unsigned*)((const char*)(gbase) + (voff)[_i]), (PG8_LAS unsigned*)(lds + (bufoff) + ldsw + _i * 8192), 16, 0, 0); } while (0)
#define PG8_LDA(dst, b, h) do { _Pragma("unroll") for (int m = 0; m < 4; ++m) _Pragma("unroll") for (int k = 0; k < 2; ++k) dst[m][k] = *(const PG8_LAS bf16x8*)(lds + PG8_SA(b, h) + aoff + m * 2048 + k * 1024); } while (0)
#define PG8_LDB(dst, b, h) do { _Pragma("unroll") for (int n = 0; n < 2; ++n) _Pragma("unroll") for (int k = 0; k < 2; ++k) dst[n][k] = *(const PG8_LAS bf16x8*)(lds + PG8_SB(b, h) + boff + n * 2048 + k * 1024); } while (0)
#define PG8_MMA(ai, bj, At, Bt) do { __builtin_amdgcn_s_setprio(1); _Pragma("unroll") for (int m = 0; m < 4; ++m) _Pragma("unroll") for (int n = 0; n < 2; ++n) _Pragma("unroll") for (int k = 0; k < 2; ++k) \
        { if constexpr (I8) acc[ai][bj][m][n] = __builtin_bit_cast(f32x4, __builtin_amdgcn_mfma_i32_16x16x64_i8(__builtin_bit_cast(i32x4, Bt[n][k]), __builtin_bit_cast(i32x4, At[m][k]), __builtin_bit_cast(i32x4, acc[ai][bj][m][n]), 0, 0, 0)); \
          else acc[ai][bj][m][n] = __builtin_amdgcn_mfma_f32_16x16x32_bf16(Bt[n][k], At[m][k], acc[ai][bj][m][n], 0, 0, 0); } __builtin_amdgcn_s_setprio(0); } while (0)
#define PG8_WAIT_V(n) asm volatile("s_waitcnt vmcnt(" #n ")" ::: "memory")
#define PG8_WAIT_L(n) asm volatile("s_waitcnt lgkmcnt(" #n ")" ::: "memory")
#define PG8_BAR __builtin_amdgcn_s_barrier()
#define PG8_SCHED __builtin_amdgcn_sched_barrier(0)
    Unit cur, nxt; int ui = 0;
    if (!S.next(0, cur)) return;
    typename Epi::Pre pre;
    f32x4 acc[2][2][4][2];
#pragma unroll
    for (int a = 0; a < 2; ++a)
#pragma unroll
        for (int b = 0; b < 2; ++b)
#pragma unroll
            for (int m = 0; m < 4; ++m)
#pragma unroll
                for (int n = 0; n < 2; ++n) acc[a][b][m][n] = (f32x4){0.f, 0.f, 0.f, 0.f};
    bf16x8 At[4][2], B0[2][2], B1[2][2];
    const size_t khstep = (size_t)K * 2;
    const char* cA = (const char*)g.A + (size_t)cur.pm * tstepA + cur.kh * khstep; const char* cB = (const char*)g.Bt + (size_t)cur.pn * tstepB + cur.kh * khstep;
    S.a_ready(cur);
    if constexpr (SP2) {
        PG8_STAGE(PG8_SB(0, 0), cB, voffB); PG8_STAGE(PG8_SB(0, 1), cB + hstepB, voffB); PG8_STAGE(PG8_SA(0, 0), cA, voffA); PG8_STAGE(PG8_SA(0, 1), cA + hstepA, voffA);
        if (wr == 1) PG8_BAR;
        PG8_WAIT_V(2); PG8_BAR;
        PG8_STAGE(PG8_SB(1, 0), cB + kstep, voffB); PG8_STAGE(PG8_SA(1, 0), cA + kstep, voffA); PG8_STAGE(PG8_SB(1, 1), cB + hstepB + kstep, voffB);
        PG8_WAIT_V(6); PG8_BAR;
    } else {
        PG8_STAGE(PG8_SB(0, 0), cB, voffB); PG8_STAGE(PG8_SA(0, 0), cA, voffA); PG8_STAGE(PG8_SB(0, 1), cB + hstepB, voffB); PG8_STAGE(PG8_SA(0, 1), cA + hstepA, voffA);
        if (wr == 1) PG8_BAR;
        PG8_WAIT_V(4); PG8_BAR;
        PG8_STAGE(PG8_SB(1, 0), cB + kstep, voffB); PG8_STAGE(PG8_SA(1, 0), cA + kstep, voffA); PG8_STAGE(PG8_SB(1, 1), cB + hstepB + kstep, voffB);
        PG8_WAIT_V(6); PG8_BAR;
    }
    for (;;) {
        const bool has_next = S.next(ui + 1, nxt);
        const char* nA = has_next ? (const char*)g.A + (size_t)nxt.pm * tstepA + nxt.kh * khstep : cA; const char* nB = has_next ? (const char*)g.Bt + (size_t)nxt.pn * tstepB + nxt.kh * khstep : cB;
        for (int t = 0; t < nt; t += 2) {
            const bool last = (t == nt - 2);
            const char* a1 = cA + (size_t)(t + 1) * kstep;
            const char* a2 = last ? nA : cA + (size_t)(t + 2) * kstep; const char* b2 = last ? nB : cB + (size_t)(t + 2) * kstep;
            const char* a3 = a2 + kstep; const char* b3 = b2 + kstep;
            if (last && has_next) S.a_ready(nxt);
            if (last) E.preload(pre, cur, wr, wc, fr, fq);
            if constexpr (SP2) {
            PG8_LDB(B0, 0, 0); PG8_LDB(B1, 0, 1); PG8_SCHED; PG8_LDA(At, 0, 0); PG8_STAGE(PG8_SA(1, 1), a1 + hstepA, voffA);
            PG8_WAIT_V(8); PG8_WAIT_L(0); PG8_BAR; PG8_MMA(0, 0, At, B0); PG8_MMA(0, 1, At, B1); PG8_BAR; PG8_SCHED;
            PG8_LDA(At, 0, 1); PG8_STAGE(PG8_SB(0, 0), b2, voffB); PG8_STAGE(PG8_SB(0, 1), b2 + hstepB, voffB); PG8_STAGE(PG8_SA(0, 0), a2, voffA);
            PG8_WAIT_V(8); PG8_WAIT_L(0); PG8_BAR; PG8_MMA(1, 0, At, B0); PG8_MMA(1, 1, At, B1); PG8_BAR; PG8_SCHED;
            PG8_LDB(B0, 1, 0); PG8_LDB(B1, 1, 1); PG8_SCHED; PG8_LDA(At, 1, 0); PG8_STAGE(PG8_SA(0, 1), a2 + hstepA, voffA);
            PG8_WAIT_V(8); PG8_WAIT_L(0); PG8_BAR; PG8_MMA(0, 0, At, B0); PG8_MMA(0, 1, At, B1); PG8_BAR; PG8_SCHED;
            PG8_LDA(At, 1, 1); PG8_STAGE(PG8_SB(1, 0), b3, voffB); PG8_STAGE(PG8_SB(1, 1), b3 + hstepB, voffB); PG8_STAGE(PG8_SA(1, 0), a3, voffA);
            PG8_WAIT_V(8); PG8_WAIT_L(0); PG8_BAR; PG8_MMA(1, 0, At, B0); PG8_MMA(1, 1, At, B1); PG8_BAR; PG8_SCHED;
            } else {
            PG8_LDB(B0, 0, 0); PG8_SCHED; PG8_LDA(At, 0, 0); PG8_STAGE(PG8_SA(1, 1), a1 + hstepA, voffA);
            PG8_WAIT_L(8); PG8_BAR; PG8_WAIT_L(0); PG8_MMA(0, 0, At, B0); PG8_BAR; PG8_SCHED;
            PG8_LDB(B1, 0, 1); PG8_STAGE(PG8_SB(0, 0), b2, voffB);
            PG8_BAR; PG8_WAIT_L(0); PG8_MMA(0, 1, At, B1); PG8_BAR;
            PG8_LDA(At, 0, 1); PG8_STAGE(PG8_SA(0, 0), a2, voffA);
            PG8_BAR; PG8_WAIT_L(0); PG8_MMA(1, 0, At, B0); PG8_BAR; PG8_SCHED;
            PG8_STAGE(PG8_SB(0, 1), b2 + hstepB, voffB);
            PG8_WAIT_V(6); PG8_BAR; PG8_MMA(1, 1, At, B1); PG8_BAR;
            PG8_LDB(B0, 1, 0); PG8_SCHED; PG8_LDA(At, 1, 0); PG8_STAGE(PG8_SA(0, 1), a2 + hstepA, voffA);
            PG8_WAIT_L(8); PG8_BAR; PG8_WAIT_L(0); PG8_MMA(0, 0, At, B0); PG8_BAR; PG8_SCHED;
            PG8_LDB(B1, 1, 1); PG8_STAGE(PG8_SB(1, 0), b3, voffB);
            PG8_BAR; PG8_WAIT_L(0); PG8_MMA(0, 1, At, B1); PG8_BAR;
            PG8_LDA(At, 1, 1); PG8_STAGE(PG8_SA(1, 0), a3, voffA);
            PG8_BAR; PG8_WAIT_L(0); PG8_MMA(1, 0, At, B0); PG8_BAR; PG8_SCHED;
            PG8_STAGE(PG8_SB(1, 1), b3 + hstepB, voffB);
            PG8_WAIT_V(6); PG8_BAR; PG8_MMA(1, 1, At, B1); PG8_BAR;
            }
        }
        if constexpr (ALIGN_EPI) { if (wr == 0) PG8_BAR; }
        if constexpr (!Epi::AFTER_DRAIN) { E(acc, cur, wr, wc, fr, fq, pre); S.done(cur); }
        if (!has_next) break;
        if (nxt.kh == 0) {
#pragma unroll
        for (int a = 0; a < 2; ++a)
#pragma unroll
            for (int b = 0; b < 2; ++b)
#pragma unroll
                for (int m = 0; m < 4; ++m)
#pragma unroll
                    for (int n = 0; n < 2; ++n) acc[a][b][m][n] = (f32x4){0.f, 0.f, 0.f, 0.f};
        }
        cur = nxt; cA = nA; cB = nB; ++ui;
        if constexpr (ALIGN_EPI) { if (wr == 1) PG8_BAR; }
    }
    PG8_WAIT_V(0);
    if constexpr (!ALIGN_EPI) { if (wr == 0) PG8_BAR; }
    PG8_BAR;
    if constexpr (Epi::AFTER_DRAIN) { E.fused(acc, cur, wr, wc, fr, fq, lds, wid, lane); S.done(cur); }
#undef PG8_SA
#undef PG8_SB
#undef PG8_STAGE
#undef PG8_LDA
#undef PG8_LDB
#undef PG8_MMA
#undef PG8_WAIT_V
#undef PG8_WAIT_L
#undef PG8_BAR
#undef PG8_SCHED
}
}

constexpr int NWAVES = 8;
constexpr int DM = 1024, DIN = 5376, SEQ_P = 4096, SEQ_S = 8192, NB = 8;
constexpr int MP = NB * SEQ_P, MS = NB * SEQ_S, M = MP + MS;
static_assert(M == pg8::MROWS, "plane pitch");
constexpr size_t MiB = 1u << 20;
constexpr size_t WS_CTL = 0, CTL_ZERO_BYTES = 1 * MiB;
constexpr size_t WS_WIN = 2 * MiB, WS_WO = 13 * MiB, WS_WOUT = 15 * MiB;
constexpr size_t WS_XN = 32 * MiB;
constexpr size_t WS_QA = 224 * MiB, WS_KA = 320 * MiB, WS_VA = 416 * MiB, WS_ZA = 512 * MiB, WS_QB = 608 * MiB, WS_ZB = 704 * MiB, WS_KVB = 800 * MiB;
constexpr size_t WS_MRG = WS_QA;
constexpr size_t WS_XN8 = 848 * MiB, WS_RSC = 944 * MiB, WS_WG8 = 946 * MiB;
constexpr size_t WS_END = 952 * MiB;
constexpr int NBF = 0, NI8 = 5376;
constexpr int CW_CMAX = 8192;
constexpr int CW_BAR = 4096;
constexpr int RING_OFF = 0, RING_BYTES = 131072, LDS_BYTES = 163840, LDSCTL_OFF = LDS_BYTES - 1024, MISC_OFF = LDSCTL_OFF + 320, ATT_LDS_BYTES = LDSCTL_OFF;

#define GAS __attribute__((address_space(1)))
#define LAS __attribute__((address_space(3)))
typedef unsigned short bf16;
typedef unsigned v4u __attribute__((ext_vector_type(4)));
typedef float f32x4 __attribute__((ext_vector_type(4)));
typedef GAS unsigned gu32;
#define LDS_WAIT() asm volatile("s_waitcnt lgkmcnt(0)" ::: "memory")
#define VM_WAIT() asm volatile("s_waitcnt vmcnt(0)" ::: "memory")
__device__ __forceinline__ unsigned f2bf(float f) { unsigned u = __builtin_bit_cast(unsigned, f); return (u + 0x7fffu + ((u >> 16) & 1u)) >> 16; }
__device__ __forceinline__ unsigned pk2(float lo, float hi) { return f2bf(lo) | (f2bf(hi) << 16); }
__device__ __forceinline__ float bf2f(unsigned short b) { return __uint_as_float((unsigned)b << 16); }

#define XB_TMO      128
#define XB_XCNT(j)  (256  + 64 * (j))
#define XB_XSUB(j)  (1280 + 64 * (j))
#define XB_XGEN(j)  (2304 + 64 * (j))
#define XB_TOP      3328
#define XB_TOPGEN   3392
#define XCD_BAR_WORDS 3456
#define XB_SPIN_CAP (1u << 18)

__device__ __forceinline__ unsigned xb_ld(unsigned* p)              { return __hip_atomic_load(p, __ATOMIC_RELAXED, __HIP_MEMORY_SCOPE_AGENT); }
__device__ __forceinline__ unsigned xb_add(unsigned* p, unsigned v) { return __hip_atomic_fetch_add(p, v, __ATOMIC_RELAXED, __HIP_MEMORY_SCOPE_AGENT); }
__device__ __forceinline__ unsigned xb_xcc_id() { return (unsigned)__builtin_amdgcn_s_getreg((3 << 11) | 20) & 0xFu; }
#define XB_SPIN(cond, bar) do { unsigned _sp = 0; while (cond) { __builtin_amdgcn_s_sleep(1); \
    if ((++_sp & 255u) == 0u) { if (xb_ld(&(bar)[XB_TMO])) break; if (_sp > XB_SPIN_CAP) { atomicAdd(&(bar)[XB_TMO], 1u); break; } } } } while (0)

struct XcdBarrier {
    unsigned* bar; unsigned x;
    volatile LAS unsigned* st;
};

__device__ __forceinline__ XcdBarrier xcd_barrier_post(unsigned* bar, volatile LAS unsigned* st) {
    XcdBarrier b; b.bar = bar; b.x = xb_xcc_id(); b.st = st;
    if (threadIdx.x == 0) (void)xb_add(&bar[XB_XCNT(b.x)], 1u);
    return b;
}
__device__ __forceinline__ void xcd_barrier_complete(unsigned* bar, unsigned x, unsigned& nloc, unsigned& nx) {
    const unsigned G = gridDim.x * gridDim.y * gridDim.z;
    unsigned sum, cnt, mine, sp = 0u;
    for (;;) {
        sum = 0u; cnt = 0u; mine = 0u;
#pragma unroll
        for (unsigned j = 0; j < 16; ++j) { const unsigned c = xb_ld(&bar[XB_XCNT(j)]); sum += c; cnt += (c > 0u) ? 1u : 0u; mine = (j == x) ? c : mine; }
        if (sum == G) break;
        __builtin_amdgcn_s_sleep(1);
        if ((++sp & 255u) == 0u) { if (xb_ld(&bar[XB_TMO])) break; if (sp > XB_SPIN_CAP) { atomicAdd(&bar[XB_TMO], 1u); break; } }
    }
    nloc = mine > 0u ? mine : 1u; nx = cnt > 0u ? cnt : 1u;
}

__device__ __forceinline__ void xcd_barrier(const XcdBarrier& b) {
    asm volatile("s_waitcnt vmcnt(0)" ::: "memory");
    __syncthreads();
    if (threadIdx.x == 0) {
        unsigned* bar = b.bar;
        __builtin_amdgcn_s_waitcnt(0);
        unsigned nloc = b.st[0], nx = b.st[1];
        if (nloc == 0u) { xcd_barrier_complete(bar, b.x, nloc, nx); b.st[0] = nloc; b.st[1] = nx; }
        const unsigned old = xb_add(&bar[XB_XSUB(b.x)], 1u);
        const unsigned gen = old / nloc;
        if (old + 1u == (gen + 1u) * nloc) {
            __builtin_amdgcn_fence(__ATOMIC_RELEASE, "agent");
            asm volatile("s_waitcnt vmcnt(0)" ::: "memory");
            const unsigned og = xb_add(&bar[XB_TOP], 1u);
            const unsigned tg = og / nx;
            if (og + 1u == (tg + 1u) * nx) xb_add(&bar[XB_TOPGEN], 1u);
            else XB_SPIN(xb_ld(&bar[XB_TOPGEN]) == tg, bar);
            __builtin_amdgcn_fence(__ATOMIC_ACQUIRE, "agent");
            xb_add(&bar[XB_XGEN(b.x)], 1u);
            asm volatile("s_waitcnt vmcnt(0)" ::: "memory");
        } else {
            XB_SPIN(xb_ld(&bar[XB_XGEN(b.x)]) == gen, bar);
            __builtin_amdgcn_fence(__ATOMIC_ACQUIRE, "agent");
            asm volatile("s_waitcnt vmcnt(0)" ::: "memory");
        }
    }
    __syncthreads();
}


struct Frame {
    LAS unsigned char* lds; volatile LAS unsigned* MISC; gu32* ctl;
    int tid, lane, wave, vcu, G;
    const float *xp, *xs, *norm_g, *w_in, *qn_a, *kn_a, *rpb, *qn_b, *kn_b, *sink, *w_o_a, *w_o_b, *w_out, *t5; float* out;
    bf16 *Win_t, *Wo_t, *Wout_t, *XN, *QA, *KA, *VA, *ZA, *QB, *ZB, *KVB, *MRG; unsigned char *XN8, *WG8; float *RSC, *CS;
};
__device__ __forceinline__ float wave_sum(float v) {
#pragma unroll
    for (int o = 1; o < 64; o <<= 1) v += __shfl_xor(v, o);
    return v;
}
__device__ __forceinline__ float wave_max(float v) {
#pragma unroll
    for (int o = 1; o < 64; o <<= 1) v = fmaxf(v, __shfl_xor(v, o));
    return v;
}
__host__ __device__ __forceinline__ int colperm(int cs) { return (cs & ~255) | (((cs >> 5) & 1) << 7) | (((cs >> 6) & 3) << 5) | (cs & 31); }
__device__ __forceinline__ int src_col_bf(int nb) { const int t = nb >> 3; return (t < 2 ? 256 * t : 2048 + 256 * (t - 2)) + 32 * (nb & 7); }
__device__ __forceinline__ int src_col_i8(int nb) { return 32 * nb; }
template <int MAP> __device__ __forceinline__ int src_col(int c0, int nb) { return MAP == 0 ? c0 + 32 * nb : (MAP == 1 ? src_col_bf(nb) : src_col_i8(nb)); }
template <int MAP>
__device__ __forceinline__ void p0_transpose_item(const float* W, int ldw, int c0, int ncb, bf16* WT, int ldk, int koff, LAS float* scr, int item, int lane) {
    const int kb = item / ncb, nb = item % ncb, k0 = 64 * kb, n0 = 32 * nb; c0 = src_col<MAP>(c0, nb) - n0;
#pragma unroll 8
    for (int i = 0; i < 32; ++i) { const int kk = 2 * i + (lane >> 5); scr[kk * 33 + (lane & 31)] = W[(size_t)(k0 + kk) * ldw + c0 + n0 + (lane & 31)]; }
    LDS_WAIT(); asm volatile("" ::: "memory");
    const int c = lane & 7;
#pragma unroll
    for (int j = 0; j < 4; ++j) { const int n = (lane >> 3) + 8 * j; const LAS float* s = scr + (8 * c) * 33 + n;
        v4u o; o.x = pk2(s[0 * 33], s[1 * 33]); o.y = pk2(s[2 * 33], s[3 * 33]); o.z = pk2(s[4 * 33], s[5 * 33]); o.w = pk2(s[6 * 33], s[7 * 33]);
        *(GAS v4u*)(WT + (size_t)colperm(n0 + n) * ldk + koff + k0 + 8 * c) = o; }
    LDS_WAIT(); asm volatile("" ::: "memory");
}
__device__ __forceinline__ void p0_quant_block(const float* W, int ldw, int nb, unsigned char* W8, float* cs, LAS float* scr, LAS float* red, int wave, int lane) {
    const int n0 = 32 * nb, kw = 128 * wave;
    float mx = 0.f;
#pragma unroll 8
    for (int i = 0; i < 64; ++i) { const int kk = kw + 2 * i + (lane >> 5); mx = fmaxf(mx, fabsf(W[(size_t)kk * ldw + n0 + (lane & 31)])); }
    mx = fmaxf(mx, __shfl_xor(mx, 32));
    if (lane < 32) red[wave * 32 + lane] = mx;
    __syncthreads();
    const int c = lane & 7;
    float cmx[4];
#pragma unroll
    for (int j = 0; j < 4; ++j) { const int n = (lane >> 3) + 8 * j; float m = 0.f;
#pragma unroll
        for (int w = 0; w < NWAVES; ++w) m = fmaxf(m, red[w * 32 + n]);
        cmx[j] = fmaxf(m, 1e-30f); if (wave == 0 && c == 0) cs[n0 + n] = cmx[j] * (1.0f / 127.0f); }
#pragma unroll
    for (int hk = 0; hk < 2; ++hk) {
        const int k0 = kw + 64 * hk;
#pragma unroll 8
        for (int i = 0; i < 32; ++i) { const int kk = 2 * i + (lane >> 5); scr[kk * 33 + (lane & 31)] = W[(size_t)(k0 + kk) * ldw + n0 + (lane & 31)]; }
        LDS_WAIT(); asm volatile("" ::: "memory");
#pragma unroll
        for (int j = 0; j < 4; ++j) { const int n = (lane >> 3) + 8 * j; const LAS float* s = scr + (8 * c) * 33 + n; const float qs = 127.0f / cmx[j];
            unsigned lo = 0u, hi = 0u;
#pragma unroll
            for (int e = 0; e < 4; ++e) { lo |= ((unsigned)(int)rintf(s[e * 33] * qs) & 255u) << (8 * e); hi |= ((unsigned)(int)rintf(s[(4 + e) * 33] * qs) & 255u) << (8 * e); }
            *(GAS unsigned long long*)(W8 + (size_t)colperm(n0 + n) * 1024 + k0 + 8 * c) = (unsigned long long)lo | ((unsigned long long)hi << 32); }
        LDS_WAIT(); asm volatile("" ::: "memory");
    }
    __syncthreads();
}
template <int NR>
__device__ __forceinline__ void rms_rows(const float* const (&xrow)[NR], const float* g, bf16* const (&orow)[NR], unsigned char* const (&o8row)[NR], float* const (&rsc)[NR], int lane) {
    f32x4 v[NR][4];
#pragma unroll
    for (int r = 0; r < NR; ++r) { const GAS f32x4* xr = (const GAS f32x4*)xrow[r] + lane;
#pragma unroll
        for (int j = 0; j < 4; ++j) v[r][j] = __builtin_nontemporal_load(xr + 64 * j); }
    const GAS f32x4* gr = (const GAS f32x4*)g + lane;
    f32x4 gv[4];
#pragma unroll
    for (int j = 0; j < 4; ++j) gv[j] = gr[64 * j];
#pragma unroll
    for (int r = 0; r < NR; ++r) {
        float s = 0.f;
#pragma unroll
        for (int j = 0; j < 4; ++j) s += (v[r][j].x * v[r][j].x + v[r][j].y * v[r][j].y) + (v[r][j].z * v[r][j].z + v[r][j].w * v[r][j].w);
        const float rs = 1.0f / sqrtf(wave_sum(s) * (1.f / DM) + 1e-6f);
        float am = 0.f;
#pragma unroll
        for (int j = 0; j < 4; ++j) { v[r][j] = v[r][j] * rs * gv[j];
            am = fmaxf(fmaxf(am, fmaxf(fabsf(v[r][j].x), fabsf(v[r][j].y))), fmaxf(fabsf(v[r][j].z), fabsf(v[r][j].w)));
            }
        am = fmaxf(wave_max(am), 1e-30f); const float qs = 127.0f / am;
        GAS unsigned* q4 = (GAS unsigned*)o8row[r] + lane;
#pragma unroll
        for (int j = 0; j < 4; ++j) q4[64 * j] = ((unsigned)(int)rintf(v[r][j].x * qs) & 255u) | (((unsigned)(int)rintf(v[r][j].y * qs) & 255u) << 8) | (((unsigned)(int)rintf(v[r][j].z * qs) & 255u) << 16) | (((unsigned)(int)rintf(v[r][j].w * qs) & 255u) << 24);
        if (lane == 0) *rsc[r] = am * (1.0f / 127.0f);
    }
}
__device__ __forceinline__ void p0_prologue(Frame& F) {
    LAS float* scr = (LAS float*)(F.lds + RING_OFF + F.wave * 16384);
    const int gw = F.vcu * NWAVES + F.wave, NGW = F.G * NWAVES;
    constexpr int I_OA = (512 / 64) * (DM / 32), I_OUT = (DM / 64) * (DM / 32);
    constexpr int NITEMS = 2 * I_OA + I_OUT;
    { LAS float* red = (LAS float*)(F.lds + RING_OFF + NWAVES * 16384);
      for (int nb = F.vcu; nb < NI8 / 32; nb += F.G) p0_quant_block(F.w_in, DIN, nb, F.WG8, F.CS, scr, red, F.wave, F.lane); }
    for (int it = gw; it < NITEMS; it += NGW) {
        int r = it;
        if (r < I_OA) { p0_transpose_item<0>(F.w_o_a, DM, 0, DM / 32, F.Wo_t, DM, 0, scr, r, F.lane); continue; } r -= I_OA;
        if (r < I_OA) { p0_transpose_item<0>(F.w_o_b, DM, 0, DM / 32, F.Wo_t, DM, 512, scr, r, F.lane); continue; } r -= I_OA;
        p0_transpose_item<0>(F.w_out, DM, 0, DM / 32, F.Wout_t, DM, 0, scr, r, F.lane);
    }
    static_assert(M % 4 == 0 && MP % 4 == 0, "row quads");
    for (int m4 = gw; m4 < M / 4; m4 += NGW) {
        const float* xr[4]; bf16* orow[4]; unsigned char* o8[4]; float* rsc[4];
#pragma unroll
        for (int r = 0; r < 4; ++r) { const int m = 4 * m4 + r; xr[r] = (m < MP) ? F.xp + (size_t)m * DM : F.xs + (size_t)(m - MP) * DM; orow[r] = F.XN + (size_t)m * DM;
            o8[r] = F.XN8 + (size_t)m * DM; rsc[r] = F.RSC + m; }
        rms_rows<4>(xr, F.norm_g, orow, o8, rsc, F.lane);
    }
}
__device__ __forceinline__ int t5_bucket(int rel) {
    const int n = rel < 0 ? -rel : rel; int b;
    if (n < 8) b = n; else { const int lg = 31 - __clz(n * n); b = 8 + (lg - 6); b = b > 15 ? 15 : b; }
    return b + (rel > 0 ? 16 : 0);
}
__device__ __forceinline__ float dot8(v4u q, v4u k) {
    return (pg8::bf_lo(q.x) * pg8::bf_lo(k.x) + pg8::bf_hi(q.x) * pg8::bf_hi(k.x)) + (pg8::bf_lo(q.y) * pg8::bf_lo(k.y) + pg8::bf_hi(q.y) * pg8::bf_hi(k.y))
         + (pg8::bf_lo(q.z) * pg8::bf_lo(k.z) + pg8::bf_hi(q.z) * pg8::bf_hi(k.z)) + (pg8::bf_lo(q.w) * pg8::bf_lo(k.w) + pg8::bf_hi(q.w) * pg8::bf_hi(k.w));
}
__device__ __forceinline__ void attn_naive_A(Frame& F) {
    const int gw = F.vcu * NWAVES + F.wave, NGW = F.G * NWAVES, lane = F.lane;
    for (int idx = gw; idx < M * 8; idx += NGW) {
        const int m = idx >> 3, h = idx & 7;
        int base, t, rows;
        if (m < MP) { base = m & ~(SEQ_P - 1); t = m & (SEQ_P - 1); rows = SEQ_P / 64; } else { const int mm = m - MP; base = MP + (mm & ~(SEQ_S - 1)); t = mm & (SEQ_S - 1); rows = SEQ_S / 64; }
        const int r = t >> 6, c = t & 63;
        int rs = r - 4; rs = rs < 0 ? 0 : rs; rs = rs > rows - 8 ? rows - 8 : rs;
        int cs = c - 8; cs = cs < 0 ? 0 : cs; cs = cs > 48 ? 48 : cs;
        const GAS v4u* qp = (const GAS v4u*)(F.QA + (size_t)m * 512 + h * 64);
        v4u qv[8];
#pragma unroll
        for (int i = 0; i < 8; ++i) qv[i] = qp[i];
        float s0, s1;
#pragma unroll
        for (int jj = 0; jj < 2; ++jj) {
            const int j = lane + 64 * jj, kr = rs + (j >> 4), kc = cs + (j & 15), tok = base + kr * 64 + kc;
            const GAS v4u* kp = (const GAS v4u*)(F.KA + (size_t)tok * 512 + h * 64);
            float d = 0.f;
#pragma unroll
            for (int i = 0; i < 8; ++i) d += dot8(qv[i], kp[i]);
            d += F.rpb[(h * 15 + (kr - r + 7)) * 31 + (kc - c + 15)] * pg8::LOG2E;
            if (jj == 0) s0 = d; else s1 = d;
        }
        const float mx = wave_max(fmaxf(s0, s1));
        const float p0 = __builtin_amdgcn_exp2f(s0 - mx), p1 = __builtin_amdgcn_exp2f(s1 - mx);
        const float l = wave_sum(p0 + p1);
        float o = 0.f;
        for (int j = 0; j < 128; ++j) {
            const float pj = __shfl(j < 64 ? p0 : p1, j & 63);
            const int kr = rs + (j >> 4), kc = cs + (j & 15), tok = base + kr * 64 + kc;
            o += pj * bf2f(F.VA[(size_t)tok * 512 + h * 64 + lane]);
        }
        const float z = bf2f(F.ZA[(size_t)m * 512 + h * 64 + lane]);
        F.XN[(size_t)m * 1024 + h * 64 + lane] = (bf16)f2bf(o / l * z);
    }
}
__device__ __forceinline__ void attn_naive_B(Frame& F) {
    const int gw = F.vcu * NWAVES + F.wave, NGW = F.G * NWAVES, lane = F.lane;
    for (int idx = gw; idx < M * 8; idx += NGW) {
        const int m = idx >> 3, h = idx & 7, kvh = h >> 2;
        int base, t, L;
        if (m < MP) { base = m & ~(SEQ_P - 1); t = m & (SEQ_P - 1); L = SEQ_P; } else { const int mm = m - MP; base = MP + (mm & ~(SEQ_S - 1)); t = mm & (SEQ_S - 1); L = SEQ_S; }
        const GAS v4u* qp = (const GAS v4u*)(F.QB + (size_t)m * 512 + h * 64);
        v4u qv[8];
#pragma unroll
        for (int i = 0; i < 8; ++i) qv[i] = qp[i];
        float s[5]; float mxl = -INFINITY;
#pragma unroll
        for (int jj = 0; jj < 5; ++jj) {
            const int rel = -128 + lane + 64 * jj, j = t + rel; const bool valid = rel <= 128 && j >= 0 && j < L;
            float d = -INFINITY;
            if (valid) {
                const GAS v4u* kp = (const GAS v4u*)(F.KVB + (size_t)(base + j) * 256 + kvh * 64);
                d = 0.f;
#pragma unroll
                for (int i = 0; i < 8; ++i) d += dot8(qv[i], kp[i]);
                d += F.t5[t5_bucket(rel) * 8 + h] * pg8::LOG2E;
            }
            s[jj] = d; mxl = fmaxf(mxl, d);
        }
        const float sl = F.sink[h] * pg8::LOG2E;
        const float mx = fmaxf(wave_max(mxl), sl);
        float ps = 0.f;
#pragma unroll
        for (int jj = 0; jj < 5; ++jj) { s[jj] = __builtin_amdgcn_exp2f(s[jj] - mx); ps += s[jj]; }
        const float l = wave_sum(ps) + __builtin_amdgcn_exp2f(sl - mx);
        float o = 0.f;
#pragma unroll
        for (int jj = 0; jj < 5; ++jj) {
            for (int jl = 0; jl < 64; ++jl) {
                const int rel = -128 + jl + 64 * jj, j = t + rel;
                if (rel > 128 || j < 0 || j >= L) continue;
                const float pj = __shfl(s[jj], jl);
                o += pj * bf2f(F.KVB[(size_t)(base + j) * 256 + 128 + kvh * 64 + lane]);
            }
        }
        const float z = bf2f(F.ZB[(size_t)m * 512 + h * 64 + lane]);
        F.XN[(size_t)m * 1024 + 512 + h * 64 + lane] = (bf16)f2bf(o / l * z);
    }
}

namespace att {
typedef short bf16x8 __attribute__((ext_vector_type(8)));
typedef short s16x4 __attribute__((ext_vector_type(4)));
typedef float f32x16 __attribute__((ext_vector_type(16)));
typedef float f32x2_t __attribute__((ext_vector_type(2)));
typedef __bf16 bf16x2_t __attribute__((ext_vector_type(2)));
constexpr int KB_BYTES = 8192, DHS = 4160, VB_BYTES = 2 * DHS, BUF_BYTES = KB_BYTES + VB_BYTES;
#ifndef ATT_DPF
#define ATT_DPF 2
#endif
constexpr int DPF = ATT_DPF, NS = 4;
constexpr int L_KV = 0, L_RPB = 66560, L_T5 = L_RPB + 4096, L_ZO = L_T5 + 12288, L_Q = L_ZO + 32768, L_WSF = L_Q + 32768, L_RED = L_WSF + 2048, L_END = L_RED + 512;
static_assert(NS * BUF_BYTES <= L_RPB && L_END <= ATT_LDS_BYTES, "attention LDS map");
__device__ __forceinline__ constexpr int crow(int r, int hi) { return (r & 3) + 8 * (r >> 2) + 4 * hi; }
__device__ __forceinline__ unsigned cvtpk(float lo, float hi) { f32x2_t v = {lo, hi}; bf16x2_t b = __builtin_convertvector(v, bf16x2_t); return __builtin_bit_cast(unsigned, b); }
__device__ __forceinline__ s16x4 vtr(const LAS char* p) { return __builtin_bit_cast(s16x4, __builtin_amdgcn_ds_read_tr16_b64_v4i16((LAS s16x4*)p)); }
__device__ __forceinline__ int clampi(int v, int lo, int hi) { return v < lo ? lo : (v > hi ? hi : v); }

template <bool MASKED>
__device__ __forceinline__ void subtile(const LAS char* kp, const int (&koff)[4], const LAS char* vp, const LAS float* tab, const f32x16& colmask, const bf16x8 (&qr)[4], f32x16 (&o)[2], float& lsum) {
    bf16x8 kf[4];
#pragma unroll
    for (int d0 = 0; d0 < 4; ++d0) kf[d0] = *(const LAS bf16x8*)(kp + koff[d0]);
    f32x16 s;
#pragma unroll
    for (int r = 0; r < 16; ++r) s[r] = tab[crow(r, 0)];
    s16x4 vl[2][2], vh[2][2];
#pragma unroll
    for (int dh = 0; dh < 2; ++dh)
#pragma unroll
        for (int ks = 0; ks < 2; ++ks) { vl[dh][ks] = vtr(vp + dh * DHS + ks * 1024); vh[dh][ks] = vtr(vp + dh * DHS + ks * 1024 + 512); }
    if (MASKED) {
#pragma unroll
        for (int r = 0; r < 16; ++r) s[r] += colmask[r]; }
#pragma unroll
    for (int d0 = 0; d0 < 4; ++d0) s = __builtin_amdgcn_mfma_f32_32x32x16_bf16(kf[d0], qr[d0], s, 0, 0, 0);
    float a0 = 0.f, a1 = 0.f;
#pragma unroll
    for (int r = 0; r < 16; r += 2) { s[r] = __builtin_amdgcn_exp2f(s[r]); s[r + 1] = __builtin_amdgcn_exp2f(s[r + 1]); a0 += s[r]; a1 += s[r + 1]; }
    lsum += a0 + a1;
    v4u pw0, pw1;
    pw0.x = cvtpk(s[0], s[1]); pw0.y = cvtpk(s[2], s[3]); pw0.z = cvtpk(s[4], s[5]); pw0.w = cvtpk(s[6], s[7]);
    pw1.x = cvtpk(s[8], s[9]); pw1.y = cvtpk(s[10], s[11]); pw1.z = cvtpk(s[12], s[13]); pw1.w = cvtpk(s[14], s[15]);
#pragma unroll
    for (int dh = 0; dh < 2; ++dh) {
        const bf16x8 v0 = (bf16x8){vl[dh][0][0], vl[dh][0][1], vl[dh][0][2], vl[dh][0][3], vh[dh][0][0], vh[dh][0][1], vh[dh][0][2], vh[dh][0][3]};
        const bf16x8 v1 = (bf16x8){vl[dh][1][0], vl[dh][1][1], vl[dh][1][2], vl[dh][1][3], vh[dh][1][0], vh[dh][1][1], vh[dh][1][2], vh[dh][1][3]};
        o[dh] = __builtin_amdgcn_mfma_f32_32x32x16_bf16(__builtin_bit_cast(bf16x8, pw0), v0, o[dh], 0, 0, 0);
        o[dh] = __builtin_amdgcn_mfma_f32_32x32x16_bf16(__builtin_bit_cast(bf16x8, pw1), v1, o[dh], 0, 0, 0);
    }
}

__device__ __forceinline__ void wave_epilogue(LAS char* L, int wave, int lane, f32x16 (&o)[2], float l, bf16* OG, int tok0, int tok1, int ocol) {
    const int r32 = lane & 31, hi = lane >> 5;
    LAS float* wsf = (LAS float*)(L + L_WSF) + wave * 64;
    LAS bf16* stg = (LAS bf16*)(L + L_ZO) + wave * 2048;
    if (hi == 0) wsf[r32] = __builtin_amdgcn_rcpf(l);
    LDS_WAIT();
#pragma unroll
    for (int r = 0; r < 16; ++r) { const int orow = crow(r, 0) + 4 * hi; const float rl = wsf[orow];
#pragma unroll
        for (int dh = 0; dh < 2; ++dh) { const int idx = orow * 64 + dh * 32 + r32; const float z = bf2f(stg[idx]); stg[idx] = (bf16)f2bf(o[dh][r] * rl * z * pg8::sigmoidf_(z)); } }
    LDS_WAIT();
#pragma unroll
    for (int i = 0; i < 4; ++i) { const int row = i * 8 + (lane >> 3), ch = lane & 7; const int tok = (row < 16 ? tok0 : tok1 - 16) + row;
        const v4u v = *(const LAS v4u*)(stg + row * 64 + ch * 8);
        *(GAS v4u*)(OG + (size_t)tok * 1024 + ocol + ch * 8) = v; }
    LDS_WAIT();
}

__device__ __forceinline__ void setup(Frame& F, LAS char* L) {
    const int tid = F.tid; LAS float* red = (LAS float*)(L + L_RED);
    float mx[6] = {0.f, 0.f, 0.f, 0.f, 0.f, 0.f};
    if (tid < 64) { mx[0] = fabsf(F.qn_a[tid]); mx[1] = fabsf(F.kn_a[tid]); mx[2] = fabsf(F.qn_b[tid]); mx[3] = fabsf(F.kn_b[tid]); }
    for (int i = tid; i < 8 * 15 * 31; i += NWAVES * 64) mx[4] = fmaxf(mx[4], fabsf(F.rpb[i]));
    if (tid < 256) mx[5] = fabsf(F.t5[tid]);
    if (tid < 8) mx[5] = fmaxf(mx[5], fabsf(F.sink[tid]));
#pragma unroll
    for (int k = 0; k < 6; ++k) { const float v = wave_max(mx[k]); if (F.lane == 0) red[F.wave * 6 + k] = v; }
    __syncthreads();
#pragma unroll
    for (int k = 0; k < 6; ++k) { float v = 0.f;
#pragma unroll
        for (int w = 0; w < NWAVES; ++w) v = fmaxf(v, red[w * 6 + k]); mx[k] = v; }
    const float M0a = pg8::C2 * 64.f * mx[0] * mx[1] + pg8::LOG2E * mx[4], M0b = pg8::C2 * 64.f * mx[2] * mx[3] + pg8::LOG2E * mx[5];
    LAS float* t5L = (LAS float*)(L + L_T5);
    for (int i = tid; i < 8 * 384; i += NWAVES * 64) { const int h = i / 384, rel = (i % 384) - 192; const int n = rel < 0 ? -rel : rel;
        t5L[i] = (n <= 128) ? F.t5[t5_bucket(rel) * 8 + h] * pg8::LOG2E - M0b : -INFINITY; }
    __syncthreads();
    if (tid == 0) { red[48] = M0b; red[49] = M0a; }
    __syncthreads();
}

__device__ __forceinline__ void glds16(const void* gsrc, unsigned lds_dst) { unsigned keep;
    asm volatile("s_mov_b32 %0, m0\n\ts_mov_b32 m0, %2\n\ts_nop 0\n\tglobal_load_lds_dwordx4 %1, off\n\ts_mov_b32 m0, %0" : "=&s"(keep) : "v"(gsrc), "s"(lds_dst) : "memory"); }
#define ATT_WAIT_BAR(N) asm volatile("s_waitcnt vmcnt(" #N ") lgkmcnt(0)\n\ts_barrier" ::: "memory")
#define ATT_WB_CASE(N) case N: ATT_WAIT_BAR(N); break;
__device__ __forceinline__ void wait_bar(int n) {
    switch (n < 0 ? 0 : (n > 20 ? 20 : n)) { ATT_WB_CASE(0) ATT_WB_CASE(1) ATT_WB_CASE(2) ATT_WB_CASE(3) ATT_WB_CASE(4) ATT_WB_CASE(5) ATT_WB_CASE(6) ATT_WB_CASE(7) ATT_WB_CASE(8) ATT_WB_CASE(9) ATT_WB_CASE(10)
        ATT_WB_CASE(11) ATT_WB_CASE(12) ATT_WB_CASE(13) ATT_WB_CASE(14) ATT_WB_CASE(15) ATT_WB_CASE(16) ATT_WB_CASE(17) ATT_WB_CASE(18) ATT_WB_CASE(19) default: ATT_WAIT_BAR(20); break; } }
#define ATT_WV_CASE(N) case N: asm volatile("s_waitcnt vmcnt(" #N ")" ::: "memory"); break;
__device__ __forceinline__ void wait_vm(int n) {
    switch (n < 0 ? 0 : (n > 20 ? 20 : n)) { ATT_WV_CASE(0) ATT_WV_CASE(1) ATT_WV_CASE(2) ATT_WV_CASE(3) ATT_WV_CASE(4) ATT_WV_CASE(5) ATT_WV_CASE(6) ATT_WV_CASE(7) ATT_WV_CASE(8) ATT_WV_CASE(9) ATT_WV_CASE(10)
        ATT_WV_CASE(11) ATT_WV_CASE(12) ATT_WV_CASE(13) ATT_WV_CASE(14) ATT_WV_CASE(15) ATT_WV_CASE(16) ATT_WV_CASE(17) ATT_WV_CASE(18) ATT_WV_CASE(19) default: asm volatile("s_waitcnt vmcnt(20)" ::: "memory"); break; } }
struct VmBook {
    int since_pair, since_z, since_q;
    __device__ __forceinline__ void init() { since_pair = since_z = since_q = 1 << 20; }
    __device__ __forceinline__ void issued(int n) { since_pair += n; since_z += n; since_q += n; }
};
__device__ __forceinline__ void dma_rows32(const bf16* p_lane, size_t pitch8, unsigned dst) {
#pragma unroll
    for (int i = 0; i < 4; ++i) glds16(p_lane + i * pitch8, (unsigned)__builtin_amdgcn_readfirstlane(dst + i * 1024));
}

__device__ __forceinline__ void decodeA(int ui, int& h, int& rows, int& base, int& r0) {
    int seq, rg;
    if (ui < 1024) { seq = ui >> 7; h = (ui >> 4) & 7; rg = ui & 15; rows = SEQ_P / 64; base = seq * SEQ_P; }
    else { const int u2 = ui - 1024; seq = u2 >> 8; h = (u2 >> 5) & 7; rg = u2 & 31; rows = SEQ_S / 64; base = MP + seq * SEQ_S; }
    r0 = 4 * rg;
}
__device__ __forceinline__ void build_rpb(Frame& F, LAS char* L, int h) {
    LAS float* rpbL = (LAS float*)(L + L_RPB); const float M0a = ((const LAS float*)(L + L_RED))[49];
    for (int i = F.tid; i < 16 * 64; i += NWAVES * 64) { const int row = i >> 6, col = i & 63;
        float v = 0.f; if (row == 15) v = -INFINITY; else if (col >= 16 && col <= 46) v = F.rpb[(h * 15 + row) * 31 + (col - 16)] * pg8::LOG2E - M0a;
        rpbL[i] = v; }
}
__device__ __forceinline__ int rotA(int a, int T) { const int r0 = ((a + 11) / 12) * 12; return (r0 < a + T) ? r0 - a : 0; }
__device__ __forceinline__ int rowA(int a, int T, int k0, int p) { return (p < T - k0) ? a + k0 + p : a + p - (T - k0); }
struct CursorA {
    int u, t, T, k0; const bf16* pk; const bf16* pv;
    __device__ __forceinline__ void load_unit(const Frame& F, int klo, int vlo) {
        int h, rows, base, r0; decodeA(u, h, rows, base, r0);
        const int rs_lo = clampi(r0 - 4, 0, rows - 8), rs_hi = clampi(r0 - 1, 0, rows - 8) + 8; T = rs_hi - rs_lo; t = 0; k0 = rotA(rs_lo, T);
        const size_t tok = (size_t)(base + rs_lo * 64);
        pk = F.KA + ((size_t)h * M + tok) * 64 + klo; pv = F.VA + ((size_t)h * M + tok) * 64 + vlo;
    }
};
#define ATT_DMA(cur, slot) do { const unsigned so_ = (unsigned)(slot) * BUF_BYTES; glds16((cur).pk, (unsigned)__builtin_amdgcn_readfirstlane(kdst + so_)); glds16((cur).pv, (unsigned)__builtin_amdgcn_readfirstlane(vdst + so_)); } while (0)
#define ATT_QFRAGS() do { _Pragma("unroll") for (int d0 = 0; d0 < 4; ++d0) qr[d0] = *(const LAS bf16x8*)(L + L_Q + w * 4096 + r32 * 128 + (2 * d0 + hi) * 16); } while (0)

template <bool DO_COMPUTE = true, bool DO_EPI = true>
__device__ __forceinline__ void phase_A(Frame& F, LAS char* L) {
    const int lane = F.lane, w = F.wave, r32 = lane & 31, hi = lane >> 5;
    const int rp = w >> 2, cb = w & 3, c0 = 16 * cb, cw = (cb == 0) ? 0 : (cb == 1) ? 8 : (cb == 2) ? 24 : 32;
    const int c = c0 + (r32 & 15);
    const int lo = clampi(c - 8, 0, 48) - cw;
    f32x16 colmask;
#pragma unroll
    for (int r = 0; r < 16; ++r) colmask[r] = ((unsigned)(crow(r, 0) + 4 * hi - lo) < 16u) ? 0.f : -INFINITY;
    int koff[4];
    { const int row = cw + r32;
#pragma unroll
      for (int d0 = 0; d0 < 4; ++d0) koff[d0] = row * 128 + (((2 * d0 + hi) ^ ((row >> 1) & 7)) << 4); }
    const int voff = KB_BYTES + (cw + 4 * hi + ((lane & 15) >> 2)) * 64 + ((lane >> 4) & 1) * 32 + (lane & 3) * 8;
    const int krow = 8 * w + (lane >> 3), klo = krow * 64 + (((lane & 7) ^ ((krow >> 1) & 7)) << 3);
    const int vlo = (16 * (w & 3) + (lane >> 2)) * 64 + (w >> 2) * 32 + (lane & 3) * 8;
    const unsigned lds0 = (unsigned)(uintptr_t)L;
    const unsigned kdst = lds0 + L_KV + w * 1024, vdst = lds0 + L_KV + KB_BYTES + (w >> 2) * DHS + (w & 3) * 1024;
    const unsigned qdst = lds0 + L_Q + w * 4096, zdst = lds0 + L_ZO + w * 4096;
    const int qz_lane = (lane >> 3) * 64 + (lane & 7) * 8;
    const LAS float* rpbL = (const LAS float*)(L + L_RPB);
    const int NU = 3072;
    CursorA cur; cur.u = F.vcu; cur.load_unit(F, klo, vlo);
    int cur_h; { int rows_, base_, r0_; decodeA(F.vcu, cur_h, rows_, base_, r0_); }
    build_rpb(F, L, cur_h);
#define ATT_A_PIECE(P, uu, dst, i) do { int h_, rows_, base_, r0_; decodeA((uu), h_, rows_, base_, r0_); \
        glds16((P) + ((size_t)h_ * M + (size_t)(base_ + (r0_ + 2 * rp) * 64 + c0 + ((i) >> 1) * 64 + ((i) & 1) * 8)) * 64 + qz_lane, (unsigned)__builtin_amdgcn_readfirstlane((dst) + (i) * 1024)); } while (0)
    VmBook vb; vb.init();
#pragma unroll
    for (int i = 0; i < 4; ++i) ATT_A_PIECE(F.QA, F.vcu, qdst, i);
    vb.issued(4); vb.since_q = 0;
    bool more = true; int wslot = 0, rslot = 0;
#define ATT_ISSUE_TILE() do { { const size_t ro_ = (size_t)(rowA(0, cur.T, cur.k0, cur.t)) * (64 * 64); const unsigned so_ = (unsigned)wslot * BUF_BYTES; \
            glds16(cur.pk + ro_, (unsigned)__builtin_amdgcn_readfirstlane(kdst + so_)); glds16(cur.pv + ro_, (unsigned)__builtin_amdgcn_readfirstlane(vdst + so_)); } \
        wslot = (wslot + 1) & (NS - 1); vb.issued(2); vb.since_pair = 0; \
        if (cur.t + 1 < cur.T) { ++cur.t; } else if (cur.u + F.G < NU) { cur.u += F.G; cur.load_unit(F, klo, vlo); } else { more = false; } } while (0)
    { const int np0 = (cur.T - cur.t >= 2) ? 2 : 1; ATT_ISSUE_TILE(); if (np0 == 2) ATT_ISSUE_TILE(); }
    for (int ui = F.vcu; ui < NU; ui += F.G) {
        int h, rows, base, r0; decodeA(ui, h, rows, base, r0);
        const int rs_lo = clampi(r0 - 4, 0, rows - 8), rs_hi = clampi(r0 - 1, 0, rows - 8) + 8, T = rs_hi - rs_lo;
        const int rA = r0 + 2 * rp, r = rA + (r32 >> 4);
        const int rs_r = clampi(r - 4, 0, rows - 8), k0 = rotA(rs_lo, T);
        const int rs_w0 = clampi(rA - 4, 0, rows - 8), rs_w1 = clampi(rA - 3, 0, rows - 8) + 8;
        if (h != cur_h) { ATT_WAIT_BAR(0); build_rpb(F, L, h); cur_h = h; ATT_WAIT_BAR(0); }
        f32x16 o[2]; o[0] = f32x16{}; o[1] = f32x16{}; float lsum = 0.f;
        bf16x8 qr[4];
        const int un = (ui + F.G < NU) ? ui + F.G : ui;
        int ss = 0;
        for (int t = 0; t < T; ++ss) {
            const int n = (T - t >= 2) ? 2 : 1;
            { int w_ = vb.since_pair; if (ss == 0 && vb.since_q < w_) w_ = vb.since_q; wait_bar(w_); }
            if (ss == 0) ATT_QFRAGS();
            const int np = more ? ((cur.T - cur.t >= 2) ? 2 : 1) : 0;
            if (np >= 1) ATT_ISSUE_TILE();
#pragma unroll
            for (int i = 0; i < 2; ++i) if (i < n) {
                const LAS char* buf = L + L_KV + ((rslot + i) & (NS - 1)) * BUF_BYTES;
                const int kr = rowA(rs_lo, T, k0, t + i);
                const bool valid = kr >= rs_r && kr < rs_r + 8; const int trow = valid ? kr - r + 7 : 15;
                const LAS float* tab = rpbL + (trow * 64 + 16 + cw - c + 15 + 4 * hi);
                if (DO_COMPUTE && kr >= rs_w0 && kr < rs_w1) subtile<true>(buf, koff, buf + voff, tab, colmask, qr, o, lsum);
                if (i == 0 && np >= 2) ATT_ISSUE_TILE();
            }
            if (ss == 0) {
#pragma unroll
                for (int i = 0; i < 4; ++i) ATT_A_PIECE(F.ZA, ui, zdst, i);
                vb.issued(4); vb.since_z = 0; }
            if (ss == 1) {
#pragma unroll
                for (int i = 0; i < 4; ++i) ATT_A_PIECE(F.QA, un, qdst, i);
                vb.issued(4); vb.since_q = 0; }
            rslot = (rslot + n) & (NS - 1); t += n;
        }
        { auto rr = __builtin_amdgcn_permlane32_swap(__float_as_uint(lsum), __float_as_uint(lsum), false, false); lsum = __uint_as_float(rr[0]) + __uint_as_float(rr[1]); }
        const int tok0 = base + rA * 64 + c0;
        wait_vm(vb.since_z);
        if (DO_EPI) { wave_epilogue(L, w, lane, o, lsum, F.XN, tok0, tok0 + 64, h * 64); vb.issued(4); }
    }
    ATT_WAIT_BAR(0);
#undef ATT_ISSUE_TILE
#undef ATT_A_PIECE
}

__device__ __forceinline__ void decodeB(int ui, int& kvh, int& Ls, int& base, int& p0) {
    int seq, pb;
    if (ui < 1024) { seq = ui >> 7; kvh = (ui >> 6) & 1; pb = ui & 63; Ls = SEQ_P; base = seq * SEQ_P; }
    else { const int u2 = ui - 1024; seq = u2 >> 8; kvh = (u2 >> 7) & 1; pb = u2 & 127; Ls = SEQ_S; base = MP + seq * SEQ_S; }
    p0 = 64 * pb;
}
struct CursorB {
    int u, t, T; const bf16* pk; const bf16* pv;
    __device__ __forceinline__ void load_unit(const Frame& F, int klo, int vlo) {
        int kvh, Ls, base, p0; decodeB(u, kvh, Ls, base, p0);
        int t_lo = 0, t_hi = 5; if (p0 < 128) t_lo = (128 - p0) >> 6; if (p0 + 192 > Ls) t_hi = 5 - ((p0 + 192 - Ls) >> 6);
        t = t_lo; T = t_hi;
        const long tok = (long)base + p0 - 128 + 64 * t_lo;
        pk = F.KVB + ((long)kvh * M + tok) * 64 + klo; pv = F.KVB + ((long)(2 + kvh) * M + tok) * 64 + vlo;
    }
    __device__ __forceinline__ void advance(const Frame& F, int klo, int vlo, int NU) {
        if (t + 1 < T) { ++t; pk += 64 * 64; pv += 64 * 64; }
        else if (u + F.G < NU) { u += F.G; load_unit(F, klo, vlo); }
    }
};

__device__ __forceinline__ void phase_B(Frame& F, LAS char* L) {
    const int lane = F.lane, w = F.wave, r32 = lane & 31, hi = lane >> 5;
    const int gq = w >> 1, half = w & 1;
    int koff[4];
#pragma unroll
    for (int d0 = 0; d0 < 4; ++d0) koff[d0] = r32 * 128 + (((2 * d0 + hi) ^ ((r32 >> 1) & 7)) << 4);
    const int voff = KB_BYTES + (4 * hi + ((lane & 15) >> 2)) * 64 + ((lane >> 4) & 1) * 32 + (lane & 3) * 8;
    const int krow = 8 * w + (lane >> 3), klo = krow * 64 + (((lane & 7) ^ ((krow >> 1) & 7)) << 3);
    const int vlo = (16 * (w & 3) + (lane >> 2)) * 64 + (w >> 2) * 32 + (lane & 3) * 8;
    const unsigned lds0 = (unsigned)(uintptr_t)L;
    const unsigned kdst = lds0 + L_KV + w * 1024, vdst = lds0 + L_KV + KB_BYTES + (w >> 2) * DHS + (w & 3) * 1024;
    const unsigned qdst = lds0 + L_Q + w * 4096, zdst = lds0 + L_ZO + w * 4096;
    const int qz_lane = (lane >> 3) * 64 + (lane & 7) * 8;
    const LAS float* t5L = (const LAS float*)(L + L_T5);
    const float M0b = ((const LAS float*)(L + L_RED))[48];
    const float sink_e0 = __builtin_amdgcn_exp2f(F.sink[gq] * pg8::LOG2E - M0b), sink_e1 = __builtin_amdgcn_exp2f(F.sink[4 + gq] * pg8::LOG2E - M0b);
    const f32x16 dummy = f32x16{};
    const int NU = 3072;
    CursorB cur; cur.u = F.vcu; cur.load_unit(F, klo, vlo);
#define ATT_B_PIECE(P, uu, dst, i) do { int kvh_, Ls_, base_, p0_; decodeB((uu), kvh_, Ls_, base_, p0_); \
        glds16((P) + ((size_t)(kvh_ * 4 + gq) * M + (size_t)(base_ + p0_ + 32 * half + 8 * (i))) * 64 + qz_lane, (unsigned)__builtin_amdgcn_readfirstlane((dst) + (i) * 1024)); } while (0)
    VmBook vb; vb.init();
#pragma unroll
    for (int i = 0; i < 4; ++i) ATT_B_PIECE(F.QB, F.vcu, qdst, i);
    vb.issued(4); vb.since_q = 0;
    bool more = true; int wslot = 0, rslot = 0;
#define ATT_ISSUE_TILE() do { ATT_DMA(cur, wslot); wslot = (wslot + 1) & (NS - 1); vb.issued(2); vb.since_pair = 0; \
        if (cur.t + 1 < cur.T) { ++cur.t; cur.pk += 64 * 64; cur.pv += 64 * 64; } else if (cur.u + F.G < NU) { cur.u += F.G; cur.load_unit(F, klo, vlo); } else { more = false; } } while (0)
    { const int np0 = (cur.T - cur.t >= 2) ? 2 : 1; ATT_ISSUE_TILE(); if (np0 == 2) ATT_ISSUE_TILE(); }
    for (int ui = F.vcu; ui < NU; ui += F.G) {
        int kvh, Ls, base, p0; decodeB(ui, kvh, Ls, base, p0);
        const int h = kvh * 4 + gq, pq = p0 + 32 * half, qpos = pq + r32;
        int t_lo = 0, t_hi = 5; if (p0 < 128) t_lo = (128 - p0) >> 6; if (p0 + 192 > Ls) t_hi = 5 - ((p0 + 192 - Ls) >> 6);
        f32x16 o[2]; o[0] = f32x16{}; o[1] = f32x16{}; float lsum = 0.f;
        bf16x8 qr[4];
        const int un = (ui + F.G < NU) ? ui + F.G : ui;
        int ss = 0;
        for (int t = t_lo; t < t_hi; ++ss) {
            const int n = (t_hi - t >= 2) ? 2 : 1;
            { int w_ = vb.since_pair; if (ss == 0 && vb.since_q < w_) w_ = vb.since_q; wait_bar(w_); }
            if (ss == 0) ATT_QFRAGS();
            const int np = more ? ((cur.T - cur.t >= 2) ? 2 : 1) : 0;
            if (np >= 1) ATT_ISSUE_TILE();
#pragma unroll
            for (int i = 0; i < 2; ++i) if (i < n) {
                const LAS char* buf = L + L_KV + ((rslot + i) & (NS - 1)) * BUF_BYTES;
                const LAS float* tab0 = t5L + (h * 384 + (p0 - 128 + 64 * (t + i)) - qpos + 192 + 4 * hi);
                subtile<false>(buf, koff, buf + voff, tab0, dummy, qr, o, lsum);
                if (i == 0 && np >= 2) ATT_ISSUE_TILE();
                subtile<false>(buf + 4096, koff, buf + voff + 2048, tab0 + 32, dummy, qr, o, lsum);
                if (i == 0) {
                    if (ss == 0) {
#pragma unroll
                        for (int k = 0; k < 4; ++k) ATT_B_PIECE(F.ZB, ui, zdst, k);
                        vb.issued(4); vb.since_z = 0; }
                    if (ss == 1) {
#pragma unroll
                        for (int k = 0; k < 4; ++k) ATT_B_PIECE(F.QB, un, qdst, k);
                        vb.issued(4); vb.since_q = 0; }
                }
            }
            rslot = (rslot + n) & (NS - 1); t += n;
        }
        { auto rr = __builtin_amdgcn_permlane32_swap(__float_as_uint(lsum), __float_as_uint(lsum), false, false); lsum = __uint_as_float(rr[0]) + __uint_as_float(rr[1]); }
        lsum += kvh ? sink_e1 : sink_e0;
        const int tok0 = base + pq;
        wait_vm(vb.since_z);
        wave_epilogue(L, w, lane, o, lsum, F.XN, tok0, tok0 + 16, 512 + h * 64); vb.issued(4);
    }
    ATT_WAIT_BAR(0);
#undef ATT_ISSUE_TILE
#undef ATT_B_PIECE
}
#undef ATT_DMA
#undef ATT_QFRAGS
}

#ifndef MK_N_LAUNCHES
#define MK_N_LAUNCHES 1
#endif
constexpr int N_PHASES = 5;
constexpr int N_LAUNCHES = MK_N_LAUNCHES;
struct Args { const float* in[14]; float* out; unsigned char* ws; int ph_lo, ph_hi; };
__global__ void __launch_bounds__(NWAVES * 64, 2) enc_fwd(Args args) {
    extern __shared__ __attribute__((aligned(16))) unsigned char lds[];
    Frame F;
    F.lds = (LAS unsigned char*)lds;
    F.MISC = (volatile LAS unsigned*)(F.lds + MISC_OFF);
    F.tid = threadIdx.x; F.lane = F.tid & 63; F.wave = __builtin_amdgcn_readfirstlane(F.tid >> 6);
    F.G = gridDim.x; { const int bx = blockIdx.x; F.vcu = (F.G % 8 == 0) ? (bx % 8) * (F.G / 8) + bx / 8 : bx; }
    unsigned char* ws = args.ws;
    F.ctl = (gu32*)(ws + WS_CTL);
    F.xp = args.in[0]; F.xs = args.in[1]; F.norm_g = args.in[2]; F.w_in = args.in[3]; F.qn_a = args.in[4]; F.kn_a = args.in[5]; F.rpb = args.in[6];
    F.qn_b = args.in[7]; F.kn_b = args.in[8]; F.sink = args.in[9]; F.w_o_a = args.in[10]; F.w_o_b = args.in[11]; F.w_out = args.in[12]; F.t5 = args.in[13];
    F.out = args.out;
    F.Win_t = (bf16*)(ws + WS_WIN); F.Wo_t = (bf16*)(ws + WS_WO); F.Wout_t = (bf16*)(ws + WS_WOUT);
    F.XN = (bf16*)(ws + WS_XN); F.QA = (bf16*)(ws + WS_QA); F.KA = (bf16*)(ws + WS_KA); F.VA = (bf16*)(ws + WS_VA); F.ZA = (bf16*)(ws + WS_ZA);
    F.QB = (bf16*)(ws + WS_QB); F.ZB = (bf16*)(ws + WS_ZB); F.KVB = (bf16*)(ws + WS_KVB); F.MRG = (bf16*)(ws + WS_MRG); F.XN8 = ws + WS_XN8; F.WG8 = ws + WS_WG8; F.RSC = (float*)(ws + WS_RSC); F.CS = (float*)(ws + WS_RSC + 512 * 1024);
    bf16* Gt = (bf16*)args.out;
    for (int u = F.tid; u < (LDS_BYTES - LDSCTL_OFF) / 4; u += NWAVES * 64) ((LAS unsigned*)(F.lds + LDSCTL_OFF))[u] = 0u;
    __syncthreads();
    XcdBarrier bar; bar.bar = (unsigned*)(F.ctl + CW_BAR); bar.x = 0; bar.st = nullptr;
    if (N_LAUNCHES == 1) bar = xcd_barrier_post((unsigned*)(F.ctl + CW_BAR), F.MISC + 8);
    const int lo = args.ph_lo, hi = args.ph_hi;
#define IN(k) (lo <= (k) && (k) < hi)
#define SEAM(k) do { if (IN(k) && IN((k) + 1)) xcd_barrier(bar); } while (0)

    if (IN(0)) { p0_prologue(F); SEAM(0); }
    if (IN(1)) {
        { pg8::Gemm g{(const bf16*)F.XN8, (const bf16*)F.WG8, 512, 512, 512}; pg8::StaticOrder S; S.init(M, NI8, F.G, (int)blockIdx.x);
          LAS float* csL = (LAS float*)(F.lds + RING_BYTES); LAS float* wL = csL + NI8;
          for (int i = F.tid; i < NI8; i += NWAVES * 64) csL[i] = F.CS[i];
          if (F.tid < 256) { const float* wsrc = (F.tid < 64) ? F.qn_a : (F.tid < 128) ? F.kn_a : (F.tid < 192) ? F.qn_b : F.kn_b; wL[F.tid] = wsrc[F.tid & 63]; }
          __syncthreads();
          pg8::EpiProjI8 E{F.QA, F.KA, F.VA, F.ZA, F.QB, F.KVB, F.ZB, (unsigned char*)Gt, wL, F.RSC, csL, wL + 256};
          pg8::gemm_phase<pg8::EpiProjI8, pg8::StaticOrder, true, true, true>(F.lds + RING_OFF, g, S, E); }
        SEAM(1);
    }
    if (IN(2)) {
#if defined(ATT_NAIVE)
        attn_naive_A(F); attn_naive_B(F);
#else
        LAS char* L = (LAS char*)(F.lds + RING_OFF);
        att::setup(F, L); att::phase_A(F, L); att::phase_B(F, L);
#endif
        SEAM(2);
    }
    if (IN(3)) {
        pg8::Gemm g{F.XN, F.Wo_t, DM, DM, 512}; pg8::StaticOrder S; S.init(M, DM, F.G, (int)blockIdx.x, 2);
        pg8::EpiMerge E{F.MRG, (const unsigned char*)Gt};
        pg8::gemm_phase<pg8::EpiMerge, pg8::StaticOrder, true, true>(F.lds + RING_OFF, g, S, E);
        SEAM(3);
    }
    if (IN(4)) {
        pg8::Gemm g{F.MRG, F.Wout_t, DM, DM, DM}; pg8::StaticOrder S; S.init(M, DM, F.G, (int)blockIdx.x);
        pg8::EpiOut E{F.xp, F.xs, F.out, MP};
        pg8::gemm_phase<pg8::EpiOut, pg8::StaticOrder, true, true>(F.lds + RING_OFF, g, S, E);
    }
#undef IN
#undef SEAM
}

extern "C" void kernel_launch(void* const* d_in, const int* in_sizes, int n_in, void* d_out, int out_size, void* d_ws, size_t ws_size, hipStream_t stream) {
    static int grid = 0;
    if (grid == 0) {
        if (n_in != 14 || in_sizes[0] != MP * DM || in_sizes[1] != MS * DM || out_size != M * DM || ws_size < WS_END) {
            fprintf(stderr, "kernel_launch: unexpected shapes: n_in %d in0 %d in1 %d out %d ws %zu (need %zu); nothing launched\n", n_in, n_in > 0 ? in_sizes[0] : -1, n_in > 1 ? in_sizes[1] : -1, out_size, ws_size, (size_t)WS_END); grid = -1; return; }
        int dev = 0, cus = 0, per_cu = 0;
        if (hipGetDevice(&dev) != hipSuccess || hipDeviceGetAttribute(&cus, hipDeviceAttributeMultiprocessorCount, dev) != hipSuccess) { fprintf(stderr, "kernel_launch: device query failed\n"); grid = -1; return; }
        if (hipFuncSetAttribute((const void*)enc_fwd, hipFuncAttributeMaxDynamicSharedMemorySize, LDS_BYTES) != hipSuccess) { fprintf(stderr, "kernel_launch: hipFuncSetAttribute failed\n"); grid = -1; return; }
        if (hipOccupancyMaxActiveBlocksPerMultiprocessor(&per_cu, (const void*)enc_fwd, NWAVES * 64, LDS_BYTES) != hipSuccess || per_cu < 1) {
            fprintf(stderr, "kernel_launch: occupancy query reports %d workgroups per CU; nothing launched\n", per_cu); (void)hipGetLastError(); grid = -1; return; }
        grid = cus;
    }
    if (grid < 0) return;
    if (hipMemsetAsync((char*)d_ws + WS_CTL, 0, CTL_ZERO_BYTES, stream) != hipSuccess) { fprintf(stderr, "kernel_launch: memset failed\n"); return; }
    Args a{};
    for (int i = 0; i < 14; ++i) a.in[i] = (const float*)d_in[i];
    a.out = (float*)d_out; a.ws = (unsigned char*)d_ws;
    if (N_LAUNCHES == 1) {
        a.ph_lo = 0; a.ph_hi = N_PHASES;
        void* kargs[] = {&a};
        hipError_t e = hipLaunchCooperativeKernel((const void*)enc_fwd, dim3(grid), dim3(NWAVES * 64), kargs, LDS_BYTES, stream);
        if (e != hipSuccess) fprintf(stderr, "kernel_launch: cooperative launch failed: %s (grid %d)\n", hipGetErrorString(e), grid);
    } else {
        for (int li = 0; li < N_PHASES; ++li) {
            a.ph_lo = li; a.ph_hi = li + 1;
            hipLaunchKernelGGL(enc_fwd, dim3(grid), dim3(NWAVES * 64), LDS_BYTES, stream, a);
        }
    }
}
```

```cpp
#include <hip/hip_runtime.h>
#include <cstdio>
#include <cstdint>
namespace pg8 {
#define PG8_LAS __attribute__((address_space(3)))
typedef unsigned short bf16_t;
typedef short bf16x8 __attribute__((ext_vector_type(8)));
typedef float f32x4 __attribute__((ext_vector_type(4)));
typedef unsigned u32x4 __attribute__((ext_vector_type(4)));
typedef int i32x4 __attribute__((ext_vector_type(4)));
constexpr int BM = 256, BK = 64, HALF = 128, HTB = HALF * BK * 2  , STAGE_BYTES = 8 * HTB, NXCD = 8, WGM = 8;

__host__ __device__ __forceinline__ int lds_byte(int r, int c) { const int st = (r >> 4) * 2 + (c >> 5), rr = r & 15, cc = c & 31, ob = rr * 64 + cc * 2; return st * 1024 + (ob ^ (((ob >> 9) & 1) << 5)); }
__host__ __device__ __forceinline__ void stage_rc(int b, int& R, int& C) { const int st = b / 1024, sb = b % 1024, swz = sb ^ (((sb >> 9) & 1) << 5); R = (st >> 1) * 16 + swz / 64; C = (st & 1) * 32 + (swz % 64) / 2; }
__host__ __device__ __forceinline__ int perm32(int rho) { const int n = rho >> 4, i = rho & 15; return 8 * (i >> 2) + 4 * n + (i & 3); }

struct Unit { int pm, pn, kh; };
struct Gemm { const bf16_t* A; const bf16_t* Bt; int lda, ldb, K; };

struct StaticOrder {
    int nM, nN, nwg, G, c, ks;
    __host__ __device__ void init(int M, int N, int G_, int c_, int ks_ = 1) { nM = M / BM; nN = N / BM; nwg = nM * nN; G = G_; c = c_; ks = ks_; }
    __host__ __device__ bool next(int i, Unit& u) const {
        const int it = (ks == 2) ? (i >> 1) : i; u.kh = (ks == 2) ? (i & 1) : 0;
        const long L = (long)it * G + c; if (L >= nwg) return false;
        int wgid = (int)L; { const int q = nwg / NXCD, r = nwg % NXCD, xcd = wgid % NXCD, off = wgid / NXCD; wgid = (xcd < r ? xcd * (q + 1) : r * (q + 1) + (xcd - r) * q) + off; }
        const int nig = WGM * nN, gid = wgid / nig, fm = gid * WGM, gsz = (nM - fm) < WGM ? (nM - fm) : WGM;
        u.pm = fm + ((wgid % nig) % gsz); u.pn = (wgid % nig) / gsz; return true;
    }
    __device__ __forceinline__ void a_ready(const Unit&) const {}
    __device__ __forceinline__ void done(const Unit&) const {}
};

__device__ __forceinline__ unsigned cvt_pk_bf16(float lo, float hi) { unsigned r; asm volatile("v_cvt_pk_bf16_f32 %0, %1, %2" : "=v"(r) : "v"(lo), "v"(hi)); return r; }
__device__ __forceinline__ float bf_lo(unsigned w) { return __uint_as_float(w << 16); }
__device__ __forceinline__ float bf_hi(unsigned w) { return __uint_as_float(w & 0xffff0000u); }
__device__ __forceinline__ float sigmoidf_(float v) { return __builtin_amdgcn_rcpf(1.0f + __builtin_amdgcn_exp2f(-1.4426950408889634f * v)); }

constexpr float C2 = 0.125f * 1.4426950408889634f;
constexpr float LOG2E = 1.4426950408889634f;

__device__ __forceinline__ void swap8(u32x4& a, u32x4& b, bool up) {
    const u32x4 send = up ? a : b; u32x4 recv;
#pragma unroll
    for (int k = 0; k < 4; ++k) recv[k] = (unsigned)__builtin_amdgcn_mov_dpp((int)send[k], 0x128, 0xf, 0xf, false);
    const u32x4 first = up ? recv : a, second = up ? b : recv; a = first; b = second;
}
__device__ __forceinline__ void swap8f(f32x4& a, f32x4& b, bool up) { u32x4 x = __builtin_bit_cast(u32x4, a), y = __builtin_bit_cast(u32x4, b); swap8(x, y, up); a = __builtin_bit_cast(f32x4, x); b = __builtin_bit_cast(f32x4, y); }

__device__ __forceinline__ void proj_rows(f32x4 (&v)[2][2], bool norm, float sc, const f32x4 (&wv)[2][2], bf16_t* rowp, size_t ld, bool up) {
    if (norm) {
        float ss = 0.f;
#pragma unroll
        for (int bj = 0; bj < 2; ++bj)
#pragma unroll
            for (int n = 0; n < 2; ++n) { const f32x4 x = v[bj][n]; ss += (x[0] * x[0] + x[1] * x[1]) + (x[2] * x[2] + x[3] * x[3]); }
        ss += __shfl_xor(ss, 16); ss += __shfl_xor(ss, 32);
        const float rs = __builtin_amdgcn_rsqf(ss * (1.0f / 64.0f) + 1e-6f) * sc;
#pragma unroll
        for (int bj = 0; bj < 2; ++bj)
#pragma unroll
            for (int n = 0; n < 2; ++n) v[bj][n] = v[bj][n] * rs * wv[bj][n];
    }
    u32x4 o0, o1;
    o0.x = cvt_pk_bf16(v[0][0][0], v[0][0][1]); o0.y = cvt_pk_bf16(v[0][0][2], v[0][0][3]); o0.z = cvt_pk_bf16(v[0][1][0], v[0][1][1]); o0.w = cvt_pk_bf16(v[0][1][2], v[0][1][3]);
    o1.x = cvt_pk_bf16(v[1][0][0], v[1][0][1]); o1.y = cvt_pk_bf16(v[1][0][2], v[1][0][3]); o1.z = cvt_pk_bf16(v[1][1][0], v[1][1][1]); o1.w = cvt_pk_bf16(v[1][1][2], v[1][1][3]);
    swap8(o0, o1, up);
    __builtin_nontemporal_store(o0, (u32x4*)rowp); __builtin_nontemporal_store(o1, (u32x4*)(rowp + (size_t)8 * ld));
}
struct EpiProjI8 {
    static constexpr bool PERM = true, AFTER_DRAIN = false;
    bf16_t *QA, *KA, *VA, *ZA, *QB, *KVB, *ZB; unsigned char* G8; const PG8_LAS float* wL; const float* rowscale; const PG8_LAS float* csL; PG8_LAS float* rsL;
    struct Pre {};
    __device__ __forceinline__ void preload(Pre&, const Unit& u, int wr, int wc, int fr, int fq) const {
        if (wr == 0 && wc == 0) __builtin_amdgcn_global_load_lds((const unsigned*)(rowscale + u.pm * BM + (fq * 16 + fr) * 4), (PG8_LAS unsigned*)rsL, 16, 0, 0);
    }
    __device__ __forceinline__ static float sum_fq(float x) {
        { auto rr = __builtin_amdgcn_permlane16_swap(__float_as_uint(x), __float_as_uint(x), false, false); x = __uint_as_float(rr[0]) + __uint_as_float(rr[1]); }
        { auto rr = __builtin_amdgcn_permlane32_swap(__float_as_uint(x), __float_as_uint(x), false, false); x = __uint_as_float(rr[0]) + __uint_as_float(rr[1]); }
        return x;
    }
    __device__ __forceinline__ void operator()(const f32x4 (&acc)[2][2][4][2], const Unit& u, int wr, int wc, int fr, int fq, const Pre&) const {
        const int pn = u.pn;
        const bool up = (fr & 8) != 0;
        float rs[8];
#pragma unroll
        for (int g = 0; g < 8; ++g) rs[g] = rsL[(g >> 2) * HALF + wr * 64 + (g & 3) * 16 + fr];
        f32x4 csv[2][2];
#pragma unroll
        for (int bj = 0; bj < 2; ++bj)
#pragma unroll
            for (int n = 0; n < 2; ++n) csv[bj][n] = *(const PG8_LAS f32x4*)(csL + pn * BM + wc * 64 + 32 * bj + 8 * fq + 4 * n);
        if (pn >= 13) {
            unsigned char* gp = G8 + (size_t)(u.pm * 8 + (pn - 13)) * 65536 + (size_t)(((wr * 4 + wc) * 64) + fq * 16 + fr) * 16;
#pragma unroll
            for (int bj = 0; bj < 2; ++bj)
#pragma unroll
                for (int n = 0; n < 2; ++n) csv[bj][n] = csv[bj][n] * -LOG2E;
#pragma unroll
            for (int g = 0; g < 8; ++g) {
                const float rsc = rs[g];
                u32x4 o;
#pragma unroll
                for (int bj = 0; bj < 2; ++bj)
#pragma unroll
                    for (int n = 0; n < 2; ++n) {
                        f32x4 x = __builtin_convertvector(__builtin_bit_cast(i32x4, acc[g >> 2][bj][g & 3][n]), f32x4) * (csv[bj][n] * rsc);
#pragma unroll
                        for (int i = 0; i < 4; ++i) x[i] = __builtin_amdgcn_exp2f(x[i]);
                        x = x + 1.0f;
#pragma unroll
                        for (int i = 0; i < 4; ++i) x[i] = __builtin_amdgcn_rcpf(x[i]);
                        x = x * 255.0f + 0.5f;
                        o[bj * 2 + n] = (unsigned)x[0] | ((unsigned)x[1] << 8) | ((unsigned)x[2] << 16) | ((unsigned)x[3] << 24); }
                __builtin_nontemporal_store(o, (u32x4*)(gp + g * 8192));
            }
            return;
        }
        bf16_t* base; int ld = 512, coff; int w = 64; bool norm = false; float sc = 1.0f;
        if (pn < 2)        { base = QA;  coff = pn * 256;        norm = true; w = 0; sc = C2; }
        else if (pn < 4)   { base = KA;  coff = (pn - 2) * 256;  norm = true; w = 64; }
        else if (pn < 6)   { base = VA;  coff = (pn - 4) * 256; }
        else if (pn < 8)   { base = ZA;  coff = (pn - 6) * 256; }
        else if (pn < 10)  { base = QB;  coff = (pn - 8) * 256;  norm = true; w = 128; sc = C2; }
        else if (pn == 10) { base = KVB; ld = 256; coff = 0;     norm = wc < 2; w = 192; }
        else               { base = ZB;  coff = (pn - 11) * 256; }
        const int col0 = coff + wc * 64 + 8 * fq + (up ? 32 : 0);
        const size_t ldz = (size_t)ld;
        bf16_t* const p0 = base + (size_t)(u.pm * BM + wr * 64 + (fr & 7)) * ldz + col0;
        f32x4 wv[2][2];
#pragma unroll
        for (int bj = 0; bj < 2; ++bj)
#pragma unroll
            for (int n = 0; n < 2; ++n) wv[bj][n] = *(const PG8_LAS f32x4*)(wL + w + 32 * bj + 8 * fq + 4 * n) * sc;
#pragma unroll
        for (int g = 0; g < 8; ++g) {
            const float r = rs[g];
            f32x4 v[2][2];
            if (norm) {
#pragma unroll
                for (int bj = 0; bj < 2; ++bj)
#pragma unroll
                    for (int n = 0; n < 2; ++n) v[bj][n] = __builtin_convertvector(__builtin_bit_cast(i32x4, acc[g >> 2][bj][g & 3][n]), f32x4) * csv[bj][n];
                f32x4 s4 = v[0][0] * v[0][0];
                s4 = __builtin_elementwise_fma(v[0][1], v[0][1], s4); s4 = __builtin_elementwise_fma(v[1][0], v[1][0], s4); s4 = __builtin_elementwise_fma(v[1][1], v[1][1], s4);
                const float ss = sum_fq((s4[0] + s4[1]) + (s4[2] + s4[3]));
                const float f = r * __builtin_amdgcn_rsqf((r * r) * ss * (1.0f / 64.0f) + 1e-6f);
#pragma unroll
                for (int bj = 0; bj < 2; ++bj)
#pragma unroll
                    for (int n = 0; n < 2; ++n) v[bj][n] = v[bj][n] * (wv[bj][n] * f);
            } else {
#pragma unroll
                for (int bj = 0; bj < 2; ++bj)
#pragma unroll
                    for (int n = 0; n < 2; ++n) v[bj][n] = __builtin_convertvector(__builtin_bit_cast(i32x4, acc[g >> 2][bj][g & 3][n]), f32x4) * (csv[bj][n] * r);
            }
            u32x4 o0, o1;
            o0.x = cvt_pk_bf16(v[0][0][0], v[0][0][1]); o0.y = cvt_pk_bf16(v[0][0][2], v[0][0][3]); o0.z = cvt_pk_bf16(v[0][1][0], v[0][1][1]); o0.w = cvt_pk_bf16(v[0][1][2], v[0][1][3]);
            o1.x = cvt_pk_bf16(v[1][0][0], v[1][0][1]); o1.y = cvt_pk_bf16(v[1][0][2], v[1][0][3]); o1.z = cvt_pk_bf16(v[1][1][0], v[1][1][1]); o1.w = cvt_pk_bf16(v[1][1][2], v[1][1][3]);
            swap8(o0, o1, up);
            bf16_t* rowp = p0 + (size_t)((g >> 2) * HALF + (g & 3) * 16) * ldz;
            __builtin_nontemporal_store(o0, (u32x4*)rowp); __builtin_nontemporal_store(o1, (u32x4*)(rowp + 8 * ldz));
        }
    }
};

struct EpiMerge {
    static constexpr bool PERM = true, AFTER_DRAIN = false;
    bf16_t* U; const unsigned char* G8;
    struct Pre {}; __device__ __forceinline__ void preload(Pre&, const Unit&, int, int, int, int) const {}
    __device__ __forceinline__ static f32x4 ub4(unsigned w) { return (f32x4){(float)(w & 255u), (float)((w >> 8) & 255u), (float)((w >> 16) & 255u), (float)(w >> 24)}; }
    __device__ __forceinline__ void mid(f32x4 (&acc)[2][2][4][2], const Unit& u, int wr, int wc, int fr, int fq) const {
        const unsigned char* ga = G8 + (size_t)(u.pm * 8 + u.pn) * 65536 + (size_t)(((wr * 4 + wc) * 64) + fq * 16 + fr) * 16;
        const unsigned char* gb = ga + 4 * 65536;
        u32x4 qa = *(const u32x4*)ga, qb = *(const u32x4*)gb;
#pragma unroll
        for (int c = 0; c < 8; ++c) {
            const u32x4 ca = qa, cb = qb;
            if (c + 1 < 8) { qa = *(const u32x4*)(ga + (c + 1) * 8192); qb = *(const u32x4*)(gb + (c + 1) * 8192); }
#pragma unroll
            for (int bj = 0; bj < 2; ++bj)
#pragma unroll
                for (int n = 0; n < 2; ++n) { const f32x4 a = ub4(ca[bj * 2 + n]); f32x4 b = ub4(cb[bj * 2 + n]);
#pragma unroll
                    for (int i = 0; i < 4; ++i) b[i] = __builtin_amdgcn_rcpf(fmaxf(b[i], 1.0f));
                    acc[c >> 2][bj][c & 3][n] = acc[c >> 2][bj][c & 3][n] * (a * b); }
        }
    }
    __device__ __forceinline__ void operator()(f32x4 (&acc)[2][2][4][2], const Unit& u, int wr, int wc, int fr, int fq, const Pre&) const {
        if (u.kh == 0) { mid(acc, u, wr, wc, fr, fq); return; }
        const unsigned char* gb = G8 + (size_t)(u.pm * 8 + 4 + u.pn) * 65536 + (size_t)(((wr * 4 + wc) * 64) + fq * 16 + fr) * 16;
        const bool up = (fr & 8) != 0;
        const int col0 = u.pn * BM + wc * 64 + 8 * fq + (up ? 32 : 0);
        const size_t rowb = (size_t)(u.pm * BM + wr * 64 + (fr & 7));
        u32x4 qb[8];
#pragma unroll
        for (int c = 0; c < 8; ++c) qb[c] = *(const u32x4*)(gb + c * 8192);
#pragma unroll
        for (int ai = 0; ai < 2; ++ai)
#pragma unroll
            for (int m = 0; m < 4; ++m) {
                f32x4 v[2][2];
#pragma unroll
                for (int bj = 0; bj < 2; ++bj)
#pragma unroll
                    for (int n = 0; n < 2; ++n) v[bj][n] = acc[ai][bj][m][n] * (__builtin_elementwise_max(ub4(qb[ai * 4 + m][bj * 2 + n]), (f32x4){1.f, 1.f, 1.f, 1.f}) * (1.0f / 255.0f));
                u32x4 o0, o1;
                o0.x = cvt_pk_bf16(v[0][0][0], v[0][0][1]); o0.y = cvt_pk_bf16(v[0][0][2], v[0][0][3]); o0.z = cvt_pk_bf16(v[0][1][0], v[0][1][1]); o0.w = cvt_pk_bf16(v[0][1][2], v[0][1][3]);
                o1.x = cvt_pk_bf16(v[1][0][0], v[1][0][1]); o1.y = cvt_pk_bf16(v[1][0][2], v[1][0][3]); o1.z = cvt_pk_bf16(v[1][1][0], v[1][1][1]); o1.w = cvt_pk_bf16(v[1][1][2], v[1][1][3]);
                swap8(o0, o1, up);
                bf16_t* rowp = U + (rowb + ai * HALF + m * 16) * 1024 + col0;
                *(u32x4*)rowp = o0; *(u32x4*)(rowp + (size_t)8 * 1024) = o1;
            }
    }
};

struct EpiOut {
    static constexpr bool PERM = true, AFTER_DRAIN = false;
    const float* xp; const float* xs; float* out; int MP;
    struct Pre {}; __device__ __forceinline__ void preload(Pre&, const Unit&, int, int, int, int) const {}
    __device__ __forceinline__ void operator()(const f32x4 (&acc)[2][2][4][2], const Unit& u, int wr, int wc, int fr, int fq, const Pre&) const {
        const bool up = (fr & 8) != 0;
        const int col0 = u.pn * BM + wc * 64 + 8 * fq + (up ? 4 : 0); const int r0 = u.pm * BM;
        const float* __restrict__ xb = ((r0 < MP) ? xp + (size_t)r0 * 1024 : xs + (size_t)(r0 - MP) * 1024) + (size_t)(wr * 64 + (fr & 7)) * 1024 + col0;
        float* __restrict__ ob = out + (size_t)r0 * 1024 + (size_t)(wr * 64 + (fr & 7)) * 1024 + col0;
        f32x4 xv[8][2][2];
#define EO_LOAD(g) do { _Pragma("unroll") for (int bj = 0; bj < 2; ++bj) _Pragma("unroll") for (int h = 0; h < 2; ++h) \
            xv[g][bj][h] = *(const f32x4*)(xb + (size_t)(((g) >> 2) * HALF + ((g) & 3) * 16 + 8 * h) * 1024 + 32 * bj); } while (0)
        EO_LOAD(0); EO_LOAD(1); EO_LOAD(2);
#pragma unroll
        for (int g = 0; g < 8; ++g) {
            if (g + 3 < 8) EO_LOAD(g + 3);
#pragma unroll
            for (int bj = 0; bj < 2; ++bj) { f32x4 a = acc[g >> 2][bj][g & 3][0], b = acc[g >> 2][bj][g & 3][1]; swap8f(a, b, up);
                *(f32x4*)(ob + (size_t)((g >> 2) * HALF + (g & 3) * 16) * 1024 + 32 * bj) = xv[g][bj][0] + a;
                *(f32x4*)(ob + (size_t)((g >> 2) * HALF + (g & 3) * 16 + 8) * 1024 + 32 * bj) = xv[g][bj][1] + b; }
        }
#undef EO_LOAD
    }
};

template <class Epi, class Sched, bool ALIGN_EPI = false, bool SP2 = false, bool I8 = false>
__device__ __forceinline__ void gemm_phase(PG8_LAS unsigned char* lds, const Gemm g, const Sched& S, const Epi& E) {
    const int tid = threadIdx.x, wid = __builtin_amdgcn_readfirstlane(tid >> 6), lane = tid & 63, wr = wid >> 2, wc = wid & 3, fr = lane & 15, fq = lane >> 4;
    const int K = g.K, nt = K / BK;
    unsigned voffA[2], voffB[2];
#pragma unroll
    for (int i = 0; i < 2; ++i) { int R, C; stage_rc(tid * 16 + i * 8192, R, C); const int Rb = Epi::PERM ? ((R & ~31) + perm32(R & 31)) : R;
        voffA[i] = (unsigned)(R * g.lda + C) * 2u; voffB[i] = (unsigned)(Rb * g.ldb + C) * 2u; }
    const size_t kstep = (size_t)(BK * 2);
    const size_t hstepA = (size_t)HALF * g.lda * 2, hstepB = (size_t)HALF * g.ldb * 2;
    const size_t tstepA = 2 * hstepA, tstepB = 2 * hstepB;
    const unsigned ldsw = (unsigned)wid * 1024u;
    const int aoff = lds_byte(wr * 64 + fr, fq * 8), boff = lds_byte(wc * 32 + fr, fq * 8);
#define PG8_SA(b, h) (((b) * 2 + (h)) * HTB)
#define PG8_SB(b, h) ((4 + (b) * 2 + (h)) * HTB)
#define PG8_STAGE(bufoff, gbase, voff) do { _Pragma("unroll") for (int _i = 0; _i < 2; ++_i) \
        __builtin_amdgcn_global_load_lds((const unsigned*)((const char*)(gbase) + (voff)[_i]), (PG8_LAS unsigned*)(lds + (bufoff) + ldsw + _i * 8192), 16, 0, 0); } while (0)
#define PG8_LDA(dst, b, h) do { _Pragma("unroll") for (int m = 0; m < 4; ++m) _Pragma("unroll") for (int k = 0; k < 2; ++k) dst[m][k] = *(const PG8_LAS bf16x8*)(lds + PG8_SA(b, h) + aoff + m * 2048 + k * 1024); } while (0)
#define PG8_LDB(dst, b, h) do { _Pragma("unroll") for (int n = 0; n < 2; ++n) _Pragma("unroll") for (int k = 0; k < 2; ++k) dst[n][k] = *(const PG8_LAS bf16x8*)(lds + PG8_SB(b, h) + boff + n * 2048 + k * 1024); } while (0)
#define PG8_MMA(ai, bj, At, Bt) do { __builtin_amdgcn_s_setprio(1); _Pragma("unroll") for (int m = 0; m < 4; ++m) _Pragma("unroll") for (int n = 0; n < 2; ++n) _Pragma("unroll") for (int k = 0; k < 2; ++k) \
        { if constexpr (I8) acc[ai][bj][m][n] = __builtin_bit_cast(f32x4, __builtin_amdgcn_mfma_i32_16x16x64_i8(__builtin_bit_cast(i32x4, Bt[n][k]), __builtin_bit_cast(i32x4, At[m][k]), __builtin_bit_cast(i32x4, acc[ai][bj][m][n]), 0, 0, 0)); \
          else acc[ai][bj][m][n] = __builtin_amdgcn_mfma_f32_16x16x32_bf16(Bt[n][k], At[m][k], acc[ai][bj][m][n], 0, 0, 0); } __builtin_amdgcn_s_setprio(0); } while (0)
#define PG8_WAIT_V(n) asm volatile("s_waitcnt vmcnt(" #n ")" ::: "memory")
#define PG8_WAIT_L(n) asm volatile("s_waitcnt lgkmcnt(" #n ")" ::: "memory")
#define PG8_BAR __builtin_amdgcn_s_barrier()
#define PG8_SCHED __builtin_amdgcn_sched_barrier(0)
    Unit cur, nxt; int ui = 0;
    if (!S.next(0, cur)) return;
    typename Epi::Pre pre;
    f32x4 acc[2][2][4][2];
#pragma unroll
    for (int a = 0; a < 2; ++a)
#pragma unroll
        for (int b = 0; b < 2; ++b)
#pragma unroll
            for (int m = 0; m < 4; ++m)
#pragma unroll
                for (int n = 0; n < 2; ++n) acc[a][b][m][n] = (f32x4){0.f, 0.f, 0.f, 0.f};
    bf16x8 At[4][2], B0[2][2], B1[2][2];
    const size_t khstep = (size_t)K * 2;
    const char* cA = (const char*)g.A + (size_t)cur.pm * tstepA + cur.kh * khstep; const char* cB = (const char*)g.Bt + (size_t)cur.pn * tstepB + cur.kh * khstep;
    S.a_ready(cur);
    if constexpr (SP2) {
        PG8_STAGE(PG8_SB(0, 0), cB, voffB); PG8_STAGE(PG8_SB(0, 1), cB + hstepB, voffB); PG8_STAGE(PG8_SA(0, 0), cA, voffA); PG8_STAGE(PG8_SA(0, 1), cA + hstepA, voffA);
        if (wr == 1) PG8_BAR;
        PG8_WAIT_V(2); PG8_BAR;
        PG8_STAGE(PG8_SB(1, 0), cB + kstep, voffB); PG8_STAGE(PG8_SA(1, 0), cA + kstep, voffA); PG8_STAGE(PG8_SB(1, 1), cB + hstepB + kstep, voffB);
        PG8_WAIT_V(6); PG8_BAR;
    } else {
        PG8_STAGE(PG8_SB(0, 0), cB, voffB); PG8_STAGE(PG8_SA(0, 0), cA, voffA); PG8_STAGE(PG8_SB(0, 1), cB + hstepB, voffB); PG8_STAGE(PG8_SA(0, 1), cA + hstepA, voffA);
        if (wr == 1) PG8_BAR;
        PG8_WAIT_V(4); PG8_BAR;
        PG8_STAGE(PG8_SB(1, 0), cB + kstep, voffB); PG8_STAGE(PG8_SA(1, 0), cA + kstep, voffA); PG8_STAGE(PG8_SB(1, 1), cB + hstepB + kstep, voffB);
        PG8_WAIT_V(6); PG8_BAR;
    }
    for (;;) {
        const bool has_next = S.next(ui + 1, nxt);
        const char* nA = has_next ? (const char*)g.A + (size_t)nxt.pm * tstepA + nxt.kh * khstep : cA; const char* nB = has_next ? (const char*)g.Bt + (size_t)nxt.pn * tstepB + nxt.kh * khstep : cB;
        for (int t = 0; t < nt; t += 2) {
            const bool last = (t == nt - 2);
            const char* a1 = cA + (size_t)(t + 1) * kstep;
            const char* a2 = last ? nA : cA + (size_t)(t + 2) * kstep; const char* b2 = last ? nB : cB + (size_t)(t + 2) * kstep;
            const char* a3 = a2 + kstep; const char* b3 = b2 + kstep;
            if (last && has_next) S.a_ready(nxt);
            if (last) E.preload(pre, cur, wr, wc, fr, fq);
            if constexpr (SP2) {
            PG8_LDB(B0, 0, 0); PG8_LDB(B1, 0, 1); PG8_SCHED; PG8_LDA(At, 0, 0); PG8_STAGE(PG8_SA(1, 1), a1 + hstepA, voffA);
            PG8_WAIT_V(8); PG8_WAIT_L(0); PG8_BAR; PG8_MMA(0, 0, At, B0); PG8_MMA(0, 1, At, B1); PG8_BAR; PG8_SCHED;
            PG8_LDA(At, 0, 1); PG8_STAGE(PG8_SB(0, 0), b2, voffB); PG8_STAGE(PG8_SB(0, 1), b2 + hstepB, voffB); PG8_STAGE(PG8_SA(0, 0), a2, voffA);
            PG8_WAIT_V(8); PG8_WAIT_L(0); PG8_BAR; PG8_MMA(1, 0, At, B0); PG8_MMA(1, 1, At, B1); PG8_BAR; PG8_SCHED;
            PG8_LDB(B0, 1, 0); PG8_LDB(B1, 1, 1); PG8_SCHED; PG8_LDA(At, 1, 0); PG8_STAGE(PG8_SA(0, 1), a2 + hstepA, voffA);
            PG8_WAIT_V(8); PG8_WAIT_L(0); PG8_BAR; PG8_MMA(0, 0, At, B0); PG8_MMA(0, 1, At, B1); PG8_BAR; PG8_SCHED;
            PG8_LDA(At, 1, 1); PG8_STAGE(PG8_SB(1, 0), b3, voffB); PG8_STAGE(PG8_SB(1, 1), b3 + hstepB, voffB); PG8_STAGE(PG8_SA(1, 0), a3, voffA);
            PG8_WAIT_V(8); PG8_WAIT_L(0); PG8_BAR; PG8_MMA(1, 0, At, B0); PG8_MMA(1, 1, At, B1); PG8_BAR; PG8_SCHED;
            } else {
            PG8_LDB(B0, 0, 0); PG8_SCHED; PG8_LDA(At, 0, 0); PG8_STAGE(PG8_SA(1, 1), a1 + hstepA, voffA);
            PG8_WAIT_L(8); PG8_BAR; PG8_WAIT_L(0); PG8_MMA(0, 0, At, B0); PG8_BAR; PG8_SCHED;
            PG8_LDB(B1, 0, 1); PG8_STAGE(PG8_SB(0, 0), b2, voffB);
            PG8_BAR; PG8_WAIT_L(0); PG8_MMA(0, 1, At, B1); PG8_BAR;
            PG8_LDA(At, 0, 1); PG8_STAGE(PG8_SA(0, 0), a2, voffA);
            PG8_BAR; PG8_WAIT_L(0); PG8_MMA(1, 0, At, B0); PG8_BAR; PG8_SCHED;
            PG8_STAGE(PG8_SB(0, 1), b2 + hstepB, voffB);
            PG8_WAIT_V(6); PG8_BAR; PG8_MMA(1, 1, At, B1); PG8_BAR;
            PG8_LDB(B0, 1, 0); PG8_SCHED; PG8_LDA(At, 1, 0); PG8_STAGE(PG8_SA(0, 1), a2 + hstepA, voffA);
            PG8_WAIT_L(8); PG8_BAR; PG8_WAIT_L(0); PG8_MMA(0, 0, At, B0); PG8_BAR; PG8_SCHED;
            PG8_LDB(B1, 1, 1); PG8_STAGE(PG8_SB(1, 0), b3, voffB);
            PG8_BAR; PG8_WAIT_L(0); PG8_MMA(0, 1, At, B1); PG8_BAR;
            PG8_LDA(At, 1, 1); PG8_STAGE(PG8_SA(1, 0), a3, voffA);
            PG8_BAR; PG8_WAIT_L(0); PG8_MMA(1, 0, At, B0); PG8_BAR; PG8_SCHED;
            PG8_STAGE(PG8_SB(1, 1), b3 + hstepB, voffB);
            PG8_WAIT_V(6); PG8_BAR; PG8_MMA(1, 1, At, B1); PG8_BAR;
            }
        }
        if constexpr (ALIGN_EPI) { if (wr == 0) PG8_BAR; }
        if constexpr (!Epi::AFTER_DRAIN) { E(acc, cur, wr, wc, fr, fq, pre); S.done(cur); }
        if (!has_next) break;
        if (nxt.kh == 0) {
#pragma unroll
        for (int a = 0; a < 2; ++a)
#pragma unroll
            for (int b = 0; b < 2; ++b)
#pragma unroll
                for (int m = 0; m < 4; ++m)
#pragma unroll
                    for (int n = 0; n < 2; ++n) acc[a][b][m][n] = (f32x4){0.f, 0.f, 0.f, 0.f};
        }
        cur = nxt; cA = nA; cB = nB; ++ui;
        if constexpr (ALIGN_EPI) { if (wr == 1) PG8_BAR; }
    }
    PG8_WAIT_V(0);
    if constexpr (!ALIGN_EPI) { if (wr == 0) PG8_BAR; }
    PG8_BAR;
    if constexpr (Epi::AFTER_DRAIN) { E.fused(acc, cur, wr, wc, fr, fq, lds, wid, lane); S.done(cur); }
#undef PG8_SA
#undef PG8_SB
#undef PG8_STAGE
#undef PG8_LDA
#undef PG8_LDB
#undef PG8_MMA
#undef PG8_WAIT_V
#undef PG8_WAIT_L
#undef PG8_BAR
#undef PG8_SCHED
}
}

constexpr int NWAVES = 8;
constexpr int DM = 1024, DIN = 5376, SEQ_P = 4096, SEQ_S = 8192, NB = 8;
constexpr int MP = NB * SEQ_P, MS = NB * SEQ_S, M = MP + MS;
constexpr size_t MiB = 1u << 20;
constexpr size_t WS_CTL = 0, CTL_ZERO_BYTES = 1 * MiB;
constexpr size_t WS_WIN = 2 * MiB, WS_WO = 13 * MiB, WS_WOUT = 15 * MiB;
constexpr size_t WS_XN = 32 * MiB;
constexpr size_t WS_QA = 224 * MiB, WS_KA = 320 * MiB, WS_VA = 416 * MiB, WS_ZA = 512 * MiB, WS_QB = 608 * MiB, WS_ZB = 704 * MiB, WS_KVB = 800 * MiB;
constexpr size_t WS_MRG = WS_QA;
constexpr size_t WS_XN8 = 848 * MiB, WS_RSC = 944 * MiB, WS_WG8 = 946 * MiB;
constexpr size_t WS_END = 952 * MiB;
constexpr int NBF = 0, NI8 = 5376;
constexpr int CW_CMAX = 8192;
constexpr int CW_BAR = 4096;
constexpr int RING_OFF = 0, RING_BYTES = 131072, LDS_BYTES = 163840, LDSCTL_OFF = LDS_BYTES - 1024, MISC_OFF = LDSCTL_OFF + 320, ATT_LDS_BYTES = LDSCTL_OFF;

#define GAS __attribute__((address_space(1)))
#define LAS __attribute__((address_space(3)))
typedef unsigned short bf16;
typedef unsigned v4u __attribute__((ext_vector_type(4)));
typedef float f32x4 __attribute__((ext_vector_type(4)));
typedef GAS unsigned gu32;
#define LDS_WAIT() asm volatile("s_waitcnt lgkmcnt(0)" ::: "memory")
#define VM_WAIT() asm volatile("s_waitcnt vmcnt(0)" ::: "memory")
__device__ __forceinline__ unsigned f2bf(float f) { unsigned u = __builtin_bit_cast(unsigned, f); return (u + 0x7fffu + ((u >> 16) & 1u)) >> 16; }
__device__ __forceinline__ unsigned pk2(float lo, float hi) { return f2bf(lo) | (f2bf(hi) << 16); }
__device__ __forceinline__ float bf2f(unsigned short b) { return __uint_as_float((unsigned)b << 16); }

#define XB_TMO      128
#define XB_XCNT(j)  (256  + 64 * (j))
#define XB_XSUB(j)  (1280 + 64 * (j))
#define XB_XGEN(j)  (2304 + 64 * (j))
#define XB_TOP      3328
#define XB_TOPGEN   3392
#define XCD_BAR_WORDS 3456
#define XB_SPIN_CAP (1u << 18)

__device__ __forceinline__ unsigned xb_ld(unsigned* p)              { return __hip_atomic_load(p, __ATOMIC_RELAXED, __HIP_MEMORY_SCOPE_AGENT); }
__device__ __forceinline__ unsigned xb_add(unsigned* p, unsigned v) { return __hip_atomic_fetch_add(p, v, __ATOMIC_RELAXED, __HIP_MEMORY_SCOPE_AGENT); }
__device__ __forceinline__ unsigned xb_xcc_id() { return (unsigned)__builtin_amdgcn_s_getreg((3 << 11) | 20) & 0xFu; }
#define XB_SPIN(cond, bar) do { unsigned _sp = 0; while (cond) { __builtin_amdgcn_s_sleep(1); \
    if ((++_sp & 255u) == 0u) { if (xb_ld(&(bar)[XB_TMO])) break; if (_sp > XB_SPIN_CAP) { atomicAdd(&(bar)[XB_TMO], 1u); break; } } } } while (0)

struct XcdBarrier {
    unsigned* bar; unsigned x;
    volatile LAS unsigned* st;
};

__device__ __forceinline__ XcdBarrier xcd_barrier_post(unsigned* bar, volatile LAS unsigned* st) {
    XcdBarrier b; b.bar = bar; b.x = xb_xcc_id(); b.st = st;
    if (threadIdx.x == 0) (void)xb_add(&bar[XB_XCNT(b.x)], 1u);
    return b;
}
__device__ __forceinline__ void xcd_barrier_complete(unsigned* bar, unsigned x, unsigned& nloc, unsigned& nx) {
    const unsigned G = gridDim.x * gridDim.y * gridDim.z;
    unsigned sum, cnt, mine, sp = 0u;
    for (;;) {
        sum = 0u; cnt = 0u; mine = 0u;
#pragma unroll
        for (unsigned j = 0; j < 16; ++j) { const unsigned c = xb_ld(&bar[XB_XCNT(j)]); sum += c; cnt += (c > 0u) ? 1u : 0u; mine = (j == x) ? c : mine; }
        if (sum == G) break;
        __builtin_amdgcn_s_sleep(1);
        if ((++sp & 255u) == 0u) { if (xb_ld(&bar[XB_TMO])) break; if (sp > XB_SPIN_CAP) { atomicAdd(&bar[XB_TMO], 1u); break; } }
    }
    nloc = mine > 0u ? mine : 1u; nx = cnt > 0u ? cnt : 1u;
}

__device__ __forceinline__ void xcd_barrier(const XcdBarrier& b) {
    asm volatile("s_waitcnt vmcnt(0)" ::: "memory");
    __syncthreads();
    if (threadIdx.x == 0) {
        unsigned* bar = b.bar;
        __builtin_amdgcn_s_waitcnt(0);
        unsigned nloc = b.st[0], nx = b.st[1];
        if (nloc == 0u) { xcd_barrier_complete(bar, b.x, nloc, nx); b.st[0] = nloc; b.st[1] = nx; }
        const unsigned old = xb_add(&bar[XB_XSUB(b.x)], 1u);
        const unsigned gen = old / nloc;
        if (old + 1u == (gen + 1u) * nloc) {
            __builtin_amdgcn_fence(__ATOMIC_RELEASE, "agent");
            asm volatile("s_waitcnt vmcnt(0)" ::: "memory");
            const unsigned og = xb_add(&bar[XB_TOP], 1u);
            const unsigned tg = og / nx;
            if (og + 1u == (tg + 1u) * nx) xb_add(&bar[XB_TOPGEN], 1u);
            else XB_SPIN(xb_ld(&bar[XB_TOPGEN]) == tg, bar);
            __builtin_amdgcn_fence(__ATOMIC_ACQUIRE, "agent");
            xb_add(&bar[XB_XGEN(b.x)], 1u);
            asm volatile("s_waitcnt vmcnt(0)" ::: "memory");
        } else {
            XB_SPIN(xb_ld(&bar[XB_XGEN(b.x)]) == gen, bar);
            __builtin_amdgcn_fence(__ATOMIC_ACQUIRE, "agent");
            asm volatile("s_waitcnt vmcnt(0)" ::: "memory");
        }
    }
    __syncthreads();
}


struct Frame {
    LAS unsigned char* lds; volatile LAS unsigned* MISC; gu32* ctl;
    int tid, lane, wave, vcu, G;
    const float *xp, *xs, *norm_g, *w_in, *qn_a, *kn_a, *rpb, *qn_b, *kn_b, *sink, *w_o_a, *w_o_b, *w_out, *t5; float* out;
    bf16 *Win_t, *Wo_t, *Wout_t, *XN, *QA, *KA, *VA, *ZA, *QB, *ZB, *KVB, *MRG; unsigned char *XN8, *WG8; float *RSC, *CS;
};
__device__ __forceinline__ float wave_sum(float v) {
#pragma unroll
    for (int o = 1; o < 64; o <<= 1) v += __shfl_xor(v, o);
    return v;
}
__device__ __forceinline__ float wave_max(float v) {
#pragma unroll
    for (int o = 1; o < 64; o <<= 1) v = fmaxf(v, __shfl_xor(v, o));
    return v;
}
__host__ __device__ __forceinline__ int colperm(int cs) { return (cs & ~255) | (((cs >> 5) & 1) << 7) | (((cs >> 6) & 3) << 5) | (cs & 31); }
__device__ __forceinline__ int src_col_bf(int nb) { const int t = nb >> 3; return (t < 2 ? 256 * t : 2048 + 256 * (t - 2)) + 32 * (nb & 7); }
__device__ __forceinline__ int src_col_i8(int nb) { return 32 * nb; }
template <int MAP> __device__ __forceinline__ int src_col(int c0, int nb) { return MAP == 0 ? c0 + 32 * nb : (MAP == 1 ? src_col_bf(nb) : src_col_i8(nb)); }
template <int MAP>
__device__ __forceinline__ void p0_transpose_item(const float* W, int ldw, int c0, int ncb, bf16* WT, int ldk, int koff, LAS float* scr, int item, int lane) {
    const int kb = item / ncb, nb = item % ncb, k0 = 64 * kb, n0 = 32 * nb; c0 = src_col<MAP>(c0, nb) - n0;
#pragma unroll 8
    for (int i = 0; i < 32; ++i) { const int kk = 2 * i + (lane >> 5); scr[kk * 33 + (lane & 31)] = W[(size_t)(k0 + kk) * ldw + c0 + n0 + (lane & 31)]; }
    LDS_WAIT(); asm volatile("" ::: "memory");
    const int c = lane & 7;
#pragma unroll
    for (int j = 0; j < 4; ++j) { const int n = (lane >> 3) + 8 * j; const LAS float* s = scr + (8 * c) * 33 + n;
        v4u o; o.x = pk2(s[0 * 33], s[1 * 33]); o.y = pk2(s[2 * 33], s[3 * 33]); o.z = pk2(s[4 * 33], s[5 * 33]); o.w = pk2(s[6 * 33], s[7 * 33]);
        *(GAS v4u*)(WT + (size_t)colperm(n0 + n) * ldk + koff + k0 + 8 * c) = o; }
    LDS_WAIT(); asm volatile("" ::: "memory");
}
__device__ __forceinline__ void p0_quant_block(const float* W, int ldw, int nb, unsigned char* W8, float* cs, LAS float* scr, LAS float* red, int wave, int lane) {
    const int n0 = 32 * nb, kw = 128 * wave;
    float mx = 0.f;
#pragma unroll 8
    for (int i = 0; i < 64; ++i) { const int kk = kw + 2 * i + (lane >> 5); mx = fmaxf(mx, fabsf(W[(size_t)kk * ldw + n0 + (lane & 31)])); }
    mx = fmaxf(mx, __shfl_xor(mx, 32));
    if (lane < 32) red[wave * 32 + lane] = mx;
    __syncthreads();
    const int c = lane & 7;
    float cmx[4];
#pragma unroll
    for (int j = 0; j < 4; ++j) { const int n = (lane >> 3) + 8 * j; float m = 0.f;
#pragma unroll
        for (int w = 0; w < NWAVES; ++w) m = fmaxf(m, red[w * 32 + n]);
        cmx[j] = fmaxf(m, 1e-30f); if (wave == 0 && c == 0) cs[n0 + n] = cmx[j] * (1.0f / 127.0f); }
#pragma unroll
    for (int hk = 0; hk < 2; ++hk) {
        const int k0 = kw + 64 * hk;
#pragma unroll 8
        for (int i = 0; i < 32; ++i) { const int kk = 2 * i + (lane >> 5); scr[kk * 33 + (lane & 31)] = W[(size_t)(k0 + kk) * ldw + n0 + (lane & 31)]; }
        LDS_WAIT(); asm volatile("" ::: "memory");
#pragma unroll
        for (int j = 0; j < 4; ++j) { const int n = (lane >> 3) + 8 * j; const LAS float* s = scr + (8 * c) * 33 + n; const float qs = 127.0f / cmx[j];
            unsigned lo = 0u, hi = 0u;
#pragma unroll
            for (int e = 0; e < 4; ++e) { lo |= ((unsigned)(int)rintf(s[e * 33] * qs) & 255u) << (8 * e); hi |= ((unsigned)(int)rintf(s[(4 + e) * 33] * qs) & 255u) << (8 * e); }
            *(GAS unsigned long long*)(W8 + (size_t)colperm(n0 + n) * 1024 + k0 + 8 * c) = (unsigned long long)lo | ((unsigned long long)hi << 32); }
        LDS_WAIT(); asm volatile("" ::: "memory");
    }
    __syncthreads();
}
#define WRED_STEP(OP, x, ctrl) x = OP(x, __int_as_float(__builtin_amdgcn_update_dpp(0, __float_as_int(x), ctrl, 0xf, 0xf, false)))
#define WRED_SWAP(OP, x, which) do { auto rr_ = __builtin_amdgcn_permlane##which##_swap(__float_as_uint(x), __float_as_uint(x), false, false); x = OP(__uint_as_float(rr_[0]), __uint_as_float(rr_[1])); } while (0)
__device__ __forceinline__ float wr_add(float a, float b) { return a + b; }
__device__ __forceinline__ float wr_max(float a, float b) { return fmaxf(a, b); }
__device__ __forceinline__ float wave_sum_dpp(float x) { WRED_STEP(wr_add, x, 0xB1); WRED_STEP(wr_add, x, 0x4E); WRED_STEP(wr_add, x, 0x124); WRED_STEP(wr_add, x, 0x128); WRED_SWAP(wr_add, x, 16); WRED_SWAP(wr_add, x, 32); return x; }
__device__ __forceinline__ float wave_max_dpp(float x) { WRED_STEP(wr_max, x, 0xB1); WRED_STEP(wr_max, x, 0x4E); WRED_STEP(wr_max, x, 0x124); WRED_STEP(wr_max, x, 0x128); WRED_SWAP(wr_max, x, 16); WRED_SWAP(wr_max, x, 32); return x; }
template <int NR>
__device__ __forceinline__ void rms_rows(const float* const (&xrow)[NR], const float* g, bf16* const (&orow)[NR], unsigned char* const (&o8row)[NR], float* const (&rsc)[NR], int lane) {
    f32x4 v[NR][4];
#pragma unroll
    for (int r = 0; r < NR; ++r) { const GAS f32x4* xr = (const GAS f32x4*)xrow[r] + lane;
#pragma unroll
        for (int j = 0; j < 4; ++j) v[r][j] = __builtin_nontemporal_load(xr + 64 * j); }
    const GAS f32x4* gr = (const GAS f32x4*)g + lane;
    f32x4 gv[4];
#pragma unroll
    for (int j = 0; j < 4; ++j) gv[j] = gr[64 * j];
    float ss[NR], am[NR];
#pragma unroll
    for (int r = 0; r < NR; ++r) { f32x4 s4 = v[r][0] * v[r][0];
#pragma unroll
        for (int j = 1; j < 4; ++j) s4 = __builtin_elementwise_fma(v[r][j], v[r][j], s4);
        ss[r] = (s4[0] + s4[1]) + (s4[2] + s4[3]); }
#pragma unroll
    for (int r = 0; r < NR; ++r) ss[r] = wave_sum_dpp(ss[r]);
#pragma unroll
    for (int r = 0; r < NR; ++r) { const float rs = __builtin_amdgcn_rsqf(ss[r] * (1.f / DM) + 1e-6f);
        f32x4 m4 = {0.f, 0.f, 0.f, 0.f};
#pragma unroll
        for (int j = 0; j < 4; ++j) { v[r][j] = v[r][j] * (gv[j] * rs); m4 = __builtin_elementwise_max(m4, __builtin_elementwise_abs(v[r][j])); }
        am[r] = fmaxf(fmaxf(m4[0], m4[1]), fmaxf(m4[2], m4[3])); }
#pragma unroll
    for (int r = 0; r < NR; ++r) am[r] = fmaxf(wave_max_dpp(am[r]), 1e-30f);
#pragma unroll
    for (int r = 0; r < NR; ++r) { const float qs = 127.0f * __builtin_amdgcn_rcpf(am[r]);
        GAS unsigned* q4 = (GAS unsigned*)o8row[r] + lane;
#pragma unroll
        for (int j = 0; j < 4; ++j) { const f32x4 t = __builtin_elementwise_fma(v[r][j], (f32x4){qs, qs, qs, qs}, (f32x4){12582912.f, 12582912.f, 12582912.f, 12582912.f});
            const unsigned lo = __builtin_amdgcn_perm(__float_as_uint(t[1]), __float_as_uint(t[0]), 0x0c0c0400u), hi = __builtin_amdgcn_perm(__float_as_uint(t[3]), __float_as_uint(t[2]), 0x0c0c0400u);
            q4[64 * j] = __builtin_amdgcn_perm(hi, lo, 0x05040100u); }
        if (lane == 0) *rsc[r] = am[r] * (1.0f / 127.0f); }
}
__device__ __forceinline__ void p0_prologue(Frame& F) {
    LAS float* scr = (LAS float*)(F.lds + RING_OFF + F.wave * 16384);
    const int gw = F.vcu * NWAVES + F.wave, NGW = F.G * NWAVES;
    constexpr int I_OA = (512 / 64) * (DM / 32), I_OUT = (DM / 64) * (DM / 32);
    constexpr int NITEMS = 2 * I_OA + I_OUT;
    { LAS float* red = (LAS float*)(F.lds + RING_OFF + NWAVES * 16384);
      for (int nb = F.vcu; nb < NI8 / 32; nb += F.G) p0_quant_block(F.w_in, DIN, nb, F.WG8, F.CS, scr, red, F.wave, F.lane); }
    for (int it = gw; it < NITEMS; it += NGW) {
        int r = it;
        if (r < I_OA) { p0_transpose_item<0>(F.w_o_a, DM, 0, DM / 32, F.Wo_t, DM, 0, scr, r, F.lane); continue; } r -= I_OA;
        if (r < I_OA) { p0_transpose_item<0>(F.w_o_b, DM, 0, DM / 32, F.Wo_t, DM, 512, scr, r, F.lane); continue; } r -= I_OA;
        p0_transpose_item<0>(F.w_out, DM, 0, DM / 32, F.Wout_t, DM, 0, scr, r, F.lane);
    }
    static_assert(M % 4 == 0 && MP % 4 == 0, "row quads");
    for (int m4 = gw; m4 < M / 4; m4 += NGW) {
        const float* xr[4]; bf16* orow[4]; unsigned char* o8[4]; float* rsc[4];
#pragma unroll
        for (int r = 0; r < 4; ++r) { const int m = 4 * m4 + r; xr[r] = (m < MP) ? F.xp + (size_t)m * DM : F.xs + (size_t)(m - MP) * DM; orow[r] = F.XN + (size_t)m * DM;
            o8[r] = F.XN8 + (size_t)m * DM; rsc[r] = F.RSC + m; }
        rms_rows<4>(xr, F.norm_g, orow, o8, rsc, F.lane);
    }
}
__device__ __forceinline__ int t5_bucket(int rel) {
    const int n = rel < 0 ? -rel : rel; int b;
    if (n < 8) b = n; else { const int lg = 31 - __clz(n * n); b = 8 + (lg - 6); b = b > 15 ? 15 : b; }
    return b + (rel > 0 ? 16 : 0);
}
__device__ __forceinline__ float dot8(v4u q, v4u k) {
    return (pg8::bf_lo(q.x) * pg8::bf_lo(k.x) + pg8::bf_hi(q.x) * pg8::bf_hi(k.x)) + (pg8::bf_lo(q.y) * pg8::bf_lo(k.y) + pg8::bf_hi(q.y) * pg8::bf_hi(k.y))
         + (pg8::bf_lo(q.z) * pg8::bf_lo(k.z) + pg8::bf_hi(q.z) * pg8::bf_hi(k.z)) + (pg8::bf_lo(q.w) * pg8::bf_lo(k.w) + pg8::bf_hi(q.w) * pg8::bf_hi(k.w));
}
__device__ __forceinline__ void attn_naive_A(Frame& F) {
    const int gw = F.vcu * NWAVES + F.wave, NGW = F.G * NWAVES, lane = F.lane;
    for (int idx = gw; idx < M * 8; idx += NGW) {
        const int m = idx >> 3, h = idx & 7;
        int base, t, rows;
        if (m < MP) { base = m & ~(SEQ_P - 1); t = m & (SEQ_P - 1); rows = SEQ_P / 64; } else { const int mm = m - MP; base = MP + (mm & ~(SEQ_S - 1)); t = mm & (SEQ_S - 1); rows = SEQ_S / 64; }
        const int r = t >> 6, c = t & 63;
        int rs = r - 4; rs = rs < 0 ? 0 : rs; rs = rs > rows - 8 ? rows - 8 : rs;
        int cs = c - 8; cs = cs < 0 ? 0 : cs; cs = cs > 48 ? 48 : cs;
        const GAS v4u* qp = (const GAS v4u*)(F.QA + (size_t)m * 512 + h * 64);
        v4u qv[8];
#pragma unroll
        for (int i = 0; i < 8; ++i) qv[i] = qp[i];
        float s0, s1;
#pragma unroll
        for (int jj = 0; jj < 2; ++jj) {
            const int j = lane + 64 * jj, kr = rs + (j >> 4), kc = cs + (j & 15), tok = base + kr * 64 + kc;
            const GAS v4u* kp = (const GAS v4u*)(F.KA + (size_t)tok * 512 + h * 64);
            float d = 0.f;
#pragma unroll
            for (int i = 0; i < 8; ++i) d += dot8(qv[i], kp[i]);
            d += F.rpb[(h * 15 + (kr - r + 7)) * 31 + (kc - c + 15)] * pg8::LOG2E;
            if (jj == 0) s0 = d; else s1 = d;
        }
        const float mx = wave_max(fmaxf(s0, s1));
        const float p0 = __builtin_amdgcn_exp2f(s0 - mx), p1 = __builtin_amdgcn_exp2f(s1 - mx);
        const float l = wave_sum(p0 + p1);
        float o = 0.f;
        for (int j = 0; j < 128; ++j) {
            const float pj = __shfl(j < 64 ? p0 : p1, j & 63);
            const int kr = rs + (j >> 4), kc = cs + (j & 15), tok = base + kr * 64 + kc;
            o += pj * bf2f(F.VA[(size_t)tok * 512 + h * 64 + lane]);
        }
        const float z = bf2f(F.ZA[(size_t)m * 512 + h * 64 + lane]);
        F.XN[(size_t)m * 1024 + h * 64 + lane] = (bf16)f2bf(o / l * z);
    }
}
__device__ __forceinline__ void attn_naive_B(Frame& F) {
    const int gw = F.vcu * NWAVES + F.wave, NGW = F.G * NWAVES, lane = F.lane;
    for (int idx = gw; idx < M * 8; idx += NGW) {
        const int m = idx >> 3, h = idx & 7, kvh = h >> 2;
        int base, t, L;
        if (m < MP) { base = m & ~(SEQ_P - 1); t = m & (SEQ_P - 1); L = SEQ_P; } else { const int mm = m - MP; base = MP + (mm & ~(SEQ_S - 1)); t = mm & (SEQ_S - 1); L = SEQ_S; }
        const GAS v4u* qp = (const GAS v4u*)(F.QB + (size_t)m * 512 + h * 64);
        v4u qv[8];
#pragma unroll
        for (int i = 0; i < 8; ++i) qv[i] = qp[i];
        float s[5]; float mxl = -INFINITY;
#pragma unroll
        for (int jj = 0; jj < 5; ++jj) {
            const int rel = -128 + lane + 64 * jj, j = t + rel; const bool valid = rel <= 128 && j >= 0 && j < L;
            float d = -INFINITY;
            if (valid) {
                const GAS v4u* kp = (const GAS v4u*)(F.KVB + (size_t)(base + j) * 256 + kvh * 64);
                d = 0.f;
#pragma unroll
                for (int i = 0; i < 8; ++i) d += dot8(qv[i], kp[i]);
                d += F.t5[t5_bucket(rel) * 8 + h] * pg8::LOG2E;
            }
            s[jj] = d; mxl = fmaxf(mxl, d);
        }
        const float sl = F.sink[h] * pg8::LOG2E;
        const float mx = fmaxf(wave_max(mxl), sl);
        float ps = 0.f;
#pragma unroll
        for (int jj = 0; jj < 5; ++jj) { s[jj] = __builtin_amdgcn_exp2f(s[jj] - mx); ps += s[jj]; }
        const float l = wave_sum(ps) + __builtin_amdgcn_exp2f(sl - mx);
        float o = 0.f;
#pragma unroll
        for (int jj = 0; jj < 5; ++jj) {
            for (int jl = 0; jl < 64; ++jl) {
                const int rel = -128 + jl + 64 * jj, j = t + rel;
                if (rel > 128 || j < 0 || j >= L) continue;
                const float pj = __shfl(s[jj], jl);
                o += pj * bf2f(F.KVB[(size_t)(base + j) * 256 + 128 + kvh * 64 + lane]);
            }
        }
        const float z = bf2f(F.ZB[(size_t)m * 512 + h * 64 + lane]);
        F.XN[(size_t)m * 1024 + 512 + h * 64 + lane] = (bf16)f2bf(o / l * z);
    }
}

namespace att {
typedef short bf16x8 __attribute__((ext_vector_type(8)));
typedef short s16x4 __attribute__((ext_vector_type(4)));
typedef float f32x16 __attribute__((ext_vector_type(16)));
typedef float f32x2_t __attribute__((ext_vector_type(2)));
typedef __bf16 bf16x2_t __attribute__((ext_vector_type(2)));
constexpr int KB_BYTES = 8192, DHS = 4160, VB_BYTES = 2 * DHS, BUF_BYTES = KB_BYTES + VB_BYTES;
#ifndef ATT_DPF
#define ATT_DPF 2
#endif
constexpr int DPF = ATT_DPF, NS = 4;
constexpr int L_KV = 0, L_RPB = 66560, L_T5 = L_RPB + 4096, L_ZO = L_T5 + 12288, L_Q = L_ZO + 32768, L_WSF = L_Q + 32768, L_RED = L_WSF + 2048, L_END = L_RED + 512;
static_assert(NS * BUF_BYTES <= L_RPB && L_END <= ATT_LDS_BYTES, "attention LDS map");
__device__ __forceinline__ constexpr int crow(int r, int hi) { return (r & 3) + 8 * (r >> 2) + 4 * hi; }
__device__ __forceinline__ unsigned cvtpk(float lo, float hi) { f32x2_t v = {lo, hi}; bf16x2_t b = __builtin_convertvector(v, bf16x2_t); return __builtin_bit_cast(unsigned, b); }
__device__ __forceinline__ s16x4 vtr(const LAS char* p) { return __builtin_bit_cast(s16x4, __builtin_amdgcn_ds_read_tr16_b64_v4i16((LAS s16x4*)p)); }
__device__ __forceinline__ int clampi(int v, int lo, int hi) { return v < lo ? lo : (v > hi ? hi : v); }

template <bool MASKED>
__device__ __forceinline__ void subtile(const LAS char* kp, const int (&koff)[4], const LAS char* vp, const LAS float* tab, const f32x16& colmask, const bf16x8 (&qr)[4], f32x16 (&o)[2], float& lsum) {
    bf16x8 kf[4];
#pragma unroll
    for (int d0 = 0; d0 < 4; ++d0) kf[d0] = *(const LAS bf16x8*)(kp + koff[d0]);
    f32x16 s;
#pragma unroll
    for (int r = 0; r < 16; ++r) s[r] = tab[crow(r, 0)];
    s16x4 vl[2][2], vh[2][2];
#pragma unroll
    for (int dh = 0; dh < 2; ++dh)
#pragma unroll
        for (int ks = 0; ks < 2; ++ks) { vl[dh][ks] = vtr(vp + dh * DHS + ks * 1024); vh[dh][ks] = vtr(vp + dh * DHS + ks * 1024 + 512); }
    if (MASKED) {
#pragma unroll
        for (int r = 0; r < 16; ++r) s[r] += colmask[r]; }
#pragma unroll
    for (int d0 = 0; d0 < 4; ++d0) s = __builtin_amdgcn_mfma_f32_32x32x16_bf16(kf[d0], qr[d0], s, 0, 0, 0);
    float a0 = 0.f, a1 = 0.f;
#pragma unroll
    for (int r = 0; r < 16; r += 2) { s[r] = __builtin_amdgcn_exp2f(s[r]); s[r + 1] = __builtin_amdgcn_exp2f(s[r + 1]); a0 += s[r]; a1 += s[r + 1]; }
    lsum += a0 + a1;
    v4u pw0, pw1;
    pw0.x = cvtpk(s[0], s[1]); pw0.y = cvtpk(s[2], s[3]); pw0.z = cvtpk(s[4], s[5]); pw0.w = cvtpk(s[6], s[7]);
    pw1.x = cvtpk(s[8], s[9]); pw1.y = cvtpk(s[10], s[11]); pw1.z = cvtpk(s[12], s[13]); pw1.w = cvtpk(s[14], s[15]);
#pragma unroll
    for (int dh = 0; dh < 2; ++dh) {
        const bf16x8 v0 = (bf16x8){vl[dh][0][0], vl[dh][0][1], vl[dh][0][2], vl[dh][0][3], vh[dh][0][0], vh[dh][0][1], vh[dh][0][2], vh[dh][0][3]};
        const bf16x8 v1 = (bf16x8){vl[dh][1][0], vl[dh][1][1], vl[dh][1][2], vl[dh][1][3], vh[dh][1][0], vh[dh][1][1], vh[dh][1][2], vh[dh][1][3]};
        o[dh] = __builtin_amdgcn_mfma_f32_32x32x16_bf16(__builtin_bit_cast(bf16x8, pw0), v0, o[dh], 0, 0, 0);
        o[dh] = __builtin_amdgcn_mfma_f32_32x32x16_bf16(__builtin_bit_cast(bf16x8, pw1), v1, o[dh], 0, 0, 0);
    }
}

__device__ __forceinline__ void wave_epilogue(LAS char* L, int wave, int lane, f32x16 (&o)[2], float l, bf16* OG, int tok0, int tok1, int ocol) {
    const int r32 = lane & 31, hi = lane >> 5;
    LAS float* wsf = (LAS float*)(L + L_WSF) + wave * 64;
    LAS bf16* stg = (LAS bf16*)(L + L_ZO) + wave * 2048;
    if (hi == 0) wsf[r32] = __builtin_amdgcn_rcpf(l);
    LDS_WAIT();
#pragma unroll
    for (int r = 0; r < 16; ++r) { const int orow = crow(r, 0) + 4 * hi; const float rl = wsf[orow];
#pragma unroll
        for (int dh = 0; dh < 2; ++dh) { const int idx = orow * 64 + dh * 32 + r32; const float z = bf2f(stg[idx]); stg[idx] = (bf16)f2bf(o[dh][r] * rl * z * pg8::sigmoidf_(z)); } }
    LDS_WAIT();
#pragma unroll
    for (int i = 0; i < 4; ++i) { const int row = i * 8 + (lane >> 3), ch = lane & 7; const int tok = (row < 16 ? tok0 : tok1 - 16) + row;
        const v4u v = *(const LAS v4u*)(stg + row * 64 + ch * 8);
        *(GAS v4u*)(OG + (size_t)tok * 1024 + ocol + ch * 8) = v; }
    LDS_WAIT();
}

__device__ __forceinline__ void setup(Frame& F, LAS char* L) {
    const int tid = F.tid; LAS float* red = (LAS float*)(L + L_RED);
    float mx[6] = {0.f, 0.f, 0.f, 0.f, 0.f, 0.f};
    if (tid < 64) { mx[0] = fabsf(F.qn_a[tid]); mx[1] = fabsf(F.kn_a[tid]); mx[2] = fabsf(F.qn_b[tid]); mx[3] = fabsf(F.kn_b[tid]); }
    for (int i = tid; i < 8 * 15 * 31; i += NWAVES * 64) mx[4] = fmaxf(mx[4], fabsf(F.rpb[i]));
    if (tid < 256) mx[5] = fabsf(F.t5[tid]);
    if (tid < 8) mx[5] = fmaxf(mx[5], fabsf(F.sink[tid]));
#pragma unroll
    for (int k = 0; k < 6; ++k) { const float v = wave_max(mx[k]); if (F.lane == 0) red[F.wave * 6 + k] = v; }
    __syncthreads();
#pragma unroll
    for (int k = 0; k < 6; ++k) { float v = 0.f;
#pragma unroll
        for (int w = 0; w < NWAVES; ++w) v = fmaxf(v, red[w * 6 + k]); mx[k] = v; }
    const float M0a = pg8::C2 * 64.f * mx[0] * mx[1] + pg8::LOG2E * mx[4], M0b = pg8::C2 * 64.f * mx[2] * mx[3] + pg8::LOG2E * mx[5];
    LAS float* t5L = (LAS float*)(L + L_T5);
    for (int i = tid; i < 8 * 384; i += NWAVES * 64) { const int h = i / 384, rel = (i % 384) - 192; const int n = rel < 0 ? -rel : rel;
        t5L[i] = (n <= 128) ? F.t5[t5_bucket(rel) * 8 + h] * pg8::LOG2E - M0b : -INFINITY; }
    __syncthreads();
    if (tid == 0) { red[48] = M0b; red[49] = M0a; }
    __syncthreads();
}

__device__ __forceinline__ void glds16(const void* gsrc, unsigned lds_dst) { unsigned keep;
    asm volatile("s_mov_b32 %0, m0\n\ts_mov_b32 m0, %2\n\ts_nop 0\n\tglobal_load_lds_dwordx4 %1, off\n\ts_mov_b32 m0, %0" : "=&s"(keep) : "v"(gsrc), "s"(lds_dst) : "memory"); }
#define ATT_WAIT_BAR(N) asm volatile("s_waitcnt vmcnt(" #N ") lgkmcnt(0)\n\ts_barrier" ::: "memory")
#define ATT_WB_CASE(N) case N: ATT_WAIT_BAR(N); break;
__device__ __forceinline__ void wait_bar(int n) {
    switch (n < 0 ? 0 : (n > 20 ? 20 : n)) { ATT_WB_CASE(0) ATT_WB_CASE(1) ATT_WB_CASE(2) ATT_WB_CASE(3) ATT_WB_CASE(4) ATT_WB_CASE(5) ATT_WB_CASE(6) ATT_WB_CASE(7) ATT_WB_CASE(8) ATT_WB_CASE(9) ATT_WB_CASE(10)
        ATT_WB_CASE(11) ATT_WB_CASE(12) ATT_WB_CASE(13) ATT_WB_CASE(14) ATT_WB_CASE(15) ATT_WB_CASE(16) ATT_WB_CASE(17) ATT_WB_CASE(18) ATT_WB_CASE(19) default: ATT_WAIT_BAR(20); break; } }
#define ATT_WV_CASE(N) case N: asm volatile("s_waitcnt vmcnt(" #N ")" ::: "memory"); break;
__device__ __forceinline__ void wait_vm(int n) {
    switch (n < 0 ? 0 : (n > 20 ? 20 : n)) { ATT_WV_CASE(0) ATT_WV_CASE(1) ATT_WV_CASE(2) ATT_WV_CASE(3) ATT_WV_CASE(4) ATT_WV_CASE(5) ATT_WV_CASE(6) ATT_WV_CASE(7) ATT_WV_CASE(8) ATT_WV_CASE(9) ATT_WV_CASE(10)
        ATT_WV_CASE(11) ATT_WV_CASE(12) ATT_WV_CASE(13) ATT_WV_CASE(14) ATT_WV_CASE(15) ATT_WV_CASE(16) ATT_WV_CASE(17) ATT_WV_CASE(18) ATT_WV_CASE(19) default: asm volatile("s_waitcnt vmcnt(20)" ::: "memory"); break; } }
struct VmBook {
    int since_pair, since_z, since_q;
    __device__ __forceinline__ void init() { since_pair = since_z = since_q = 1 << 20; }
    __device__ __forceinline__ void issued(int n) { since_pair += n; since_z += n; since_q += n; }
};
__device__ __forceinline__ void dma_rows32(const bf16* p_lane, size_t pitch8, unsigned dst) {
#pragma unroll
    for (int i = 0; i < 4; ++i) glds16(p_lane + i * pitch8, (unsigned)__builtin_amdgcn_readfirstlane(dst + i * 1024));
}

__device__ __forceinline__ void decodeA(int ui, int& h, int& rows, int& base, int& r0) {
    int seq, rg;
    if (ui < 1024) { seq = ui >> 7; h = (ui >> 4) & 7; rg = ui & 15; rows = SEQ_P / 64; base = seq * SEQ_P; }
    else { const int u2 = ui - 1024; seq = u2 >> 8; h = (u2 >> 5) & 7; rg = u2 & 31; rows = SEQ_S / 64; base = MP + seq * SEQ_S; }
    r0 = 4 * rg;
}
__device__ __forceinline__ void build_rpb(Frame& F, LAS char* L, int h) {
    LAS float* rpbL = (LAS float*)(L + L_RPB); const float M0a = ((const LAS float*)(L + L_RED))[49];
    for (int i = F.tid; i < 16 * 64; i += NWAVES * 64) { const int row = i >> 6, col = i & 63;
        float v = 0.f; if (row == 15) v = -INFINITY; else if (col >= 16 && col <= 46) v = F.rpb[(h * 15 + row) * 31 + (col - 16)] * pg8::LOG2E - M0a;
        rpbL[i] = v; }
}
__device__ __forceinline__ int rotA(int a, int T) { const int r0 = ((a + 11) / 12) * 12; return (r0 < a + T) ? r0 - a : 0; }
__device__ __forceinline__ int rowA(int a, int T, int k0, int p) { return (p < T - k0) ? a + k0 + p : a + p - (T - k0); }
struct CursorA {
    int u, t, T, k0; const bf16* pk; const bf16* pv;
    __device__ __forceinline__ void load_unit(const Frame& F, int klo, int vlo) {
        int h, rows, base, r0; decodeA(u, h, rows, base, r0);
        const int rs_lo = clampi(r0 - 4, 0, rows - 8), rs_hi = clampi(r0 - 1, 0, rows - 8) + 8; T = rs_hi - rs_lo; t = 0; k0 = rotA(rs_lo, T);
        const size_t tok = (size_t)(base + rs_lo * 64);
        pk = F.KA + tok * 512 + h * 64 + klo; pv = F.VA + tok * 512 + h * 64 + vlo;
    }
};
#define ATT_DMA(cur, slot) do { const unsigned so_ = (unsigned)(slot) * BUF_BYTES; glds16((cur).pk, (unsigned)__builtin_amdgcn_readfirstlane(kdst + so_)); glds16((cur).pv, (unsigned)__builtin_amdgcn_readfirstlane(vdst + so_)); } while (0)
#define ATT_QFRAGS() do { _Pragma("unroll") for (int d0 = 0; d0 < 4; ++d0) qr[d0] = *(const LAS bf16x8*)(L + L_Q + w * 4096 + r32 * 128 + (2 * d0 + hi) * 16); } while (0)

template <bool DO_COMPUTE = true, bool DO_EPI = true>
__device__ __forceinline__ void phase_A(Frame& F, LAS char* L) {
    const int lane = F.lane, w = F.wave, r32 = lane & 31, hi = lane >> 5;
    const int rp = w >> 2, cb = w & 3, c0 = 16 * cb, cw = (cb == 0) ? 0 : (cb == 1) ? 8 : (cb == 2) ? 24 : 32;
    const int c = c0 + (r32 & 15);
    const int lo = clampi(c - 8, 0, 48) - cw;
    f32x16 colmask;
#pragma unroll
    for (int r = 0; r < 16; ++r) colmask[r] = ((unsigned)(crow(r, 0) + 4 * hi - lo) < 16u) ? 0.f : -INFINITY;
    int koff[4];
    { const int row = cw + r32;
#pragma unroll
      for (int d0 = 0; d0 < 4; ++d0) koff[d0] = row * 128 + (((2 * d0 + hi) ^ ((row >> 1) & 7)) << 4); }
    const int voff = KB_BYTES + (cw + 4 * hi + ((lane & 15) >> 2)) * 64 + ((lane >> 4) & 1) * 32 + (lane & 3) * 8;
    const int krow = 8 * w + (lane >> 3), klo = krow * 512 + (((lane & 7) ^ ((krow >> 1) & 7)) << 3);
    const int vlo = (16 * (w & 3) + (lane >> 2)) * 512 + (w >> 2) * 32 + (lane & 3) * 8;
    const unsigned lds0 = (unsigned)(uintptr_t)L;
    const unsigned kdst = lds0 + L_KV + w * 1024, vdst = lds0 + L_KV + KB_BYTES + (w >> 2) * DHS + (w & 3) * 1024;
    const unsigned qdst = lds0 + L_Q + w * 4096, zdst = lds0 + L_ZO + w * 4096;
    const int qz_lane = (lane >> 3) * 512 + (lane & 7) * 8;
    const LAS float* rpbL = (const LAS float*)(L + L_RPB);
    const int NU = 3072;
    CursorA cur; cur.u = F.vcu; cur.load_unit(F, klo, vlo);
    int cur_h; { int rows_, base_, r0_; decodeA(F.vcu, cur_h, rows_, base_, r0_); }
    build_rpb(F, L, cur_h);
#define ATT_A_PIECE(P, uu, dst, i) do { int h_, rows_, base_, r0_; decodeA((uu), h_, rows_, base_, r0_); \
        glds16((P) + (size_t)(base_ + (r0_ + 2 * rp) * 64 + c0 + ((i) >> 1) * 64 + ((i) & 1) * 8) * 512 + h_ * 64 + qz_lane, (unsigned)__builtin_amdgcn_readfirstlane((dst) + (i) * 1024)); } while (0)
    VmBook vb; vb.init();
#pragma unroll
    for (int i = 0; i < 4; ++i) ATT_A_PIECE(F.QA, F.vcu, qdst, i);
    vb.issued(4); vb.since_q = 0;
    bool more = true; int wslot = 0, rslot = 0;
#define ATT_ISSUE_TILE() do { { const size_t ro_ = (size_t)(rowA(0, cur.T, cur.k0, cur.t)) * (64 * 512); const unsigned so_ = (unsigned)wslot * BUF_BYTES; \
            glds16(cur.pk + ro_, (unsigned)__builtin_amdgcn_readfirstlane(kdst + so_)); glds16(cur.pv + ro_, (unsigned)__builtin_amdgcn_readfirstlane(vdst + so_)); } \
        wslot = (wslot + 1) & (NS - 1); vb.issued(2); vb.since_pair = 0; \
        if (cur.t + 1 < cur.T) { ++cur.t; } else if (cur.u + F.G < NU) { cur.u += F.G; cur.load_unit(F, klo, vlo); } else { more = false; } } while (0)
    { const int np0 = (cur.T - cur.t >= 2) ? 2 : 1; ATT_ISSUE_TILE(); if (np0 == 2) ATT_ISSUE_TILE(); }
    for (int ui = F.vcu; ui < NU; ui += F.G) {
        int h, rows, base, r0; decodeA(ui, h, rows, base, r0);
        const int rs_lo = clampi(r0 - 4, 0, rows - 8), rs_hi = clampi(r0 - 1, 0, rows - 8) + 8, T = rs_hi - rs_lo;
        const int rA = r0 + 2 * rp, r = rA + (r32 >> 4);
        const int rs_r = clampi(r - 4, 0, rows - 8), k0 = rotA(rs_lo, T);
        const int rs_w0 = clampi(rA - 4, 0, rows - 8), rs_w1 = clampi(rA - 3, 0, rows - 8) + 8;
        if (h != cur_h) { ATT_WAIT_BAR(0); build_rpb(F, L, h); cur_h = h; ATT_WAIT_BAR(0); }
        f32x16 o[2]; o[0] = f32x16{}; o[1] = f32x16{}; float lsum = 0.f;
        bf16x8 qr[4];
        const int un = (ui + F.G < NU) ? ui + F.G : ui;
        int ss = 0;
        for (int t = 0; t < T; ++ss) {
            const int n = (T - t >= 2) ? 2 : 1;
            { int w_ = vb.since_pair; if (ss == 0 && vb.since_q < w_) w_ = vb.since_q; wait_bar(w_); }
            if (ss == 0) ATT_QFRAGS();
            const int np = more ? ((cur.T - cur.t >= 2) ? 2 : 1) : 0;
            if (np >= 1) ATT_ISSUE_TILE();
#pragma unroll
            for (int i = 0; i < 2; ++i) if (i < n) {
                const LAS char* buf = L + L_KV + ((rslot + i) & (NS - 1)) * BUF_BYTES;
                const int kr = rowA(rs_lo, T, k0, t + i);
                const bool valid = kr >= rs_r && kr < rs_r + 8; const int trow = valid ? kr - r + 7 : 15;
                const LAS float* tab = rpbL + (trow * 64 + 16 + cw - c + 15 + 4 * hi);
                if (DO_COMPUTE && kr >= rs_w0 && kr < rs_w1) subtile<true>(buf, koff, buf + voff, tab, colmask, qr, o, lsum);
                if (i == 0 && np >= 2) ATT_ISSUE_TILE();
            }
            if (ss == 0) {
#pragma unroll
                for (int i = 0; i < 4; ++i) ATT_A_PIECE(F.ZA, ui, zdst, i);
                vb.issued(4); vb.since_z = 0; }
            if (ss == 1) {
#pragma unroll
                for (int i = 0; i < 4; ++i) ATT_A_PIECE(F.QA, un, qdst, i);
                vb.issued(4); vb.since_q = 0; }
            rslot = (rslot + n) & (NS - 1); t += n;
        }
        { auto rr = __builtin_amdgcn_permlane32_swap(__float_as_uint(lsum), __float_as_uint(lsum), false, false); lsum = __uint_as_float(rr[0]) + __uint_as_float(rr[1]); }
        const int tok0 = base + rA * 64 + c0;
        wait_vm(vb.since_z);
        if (DO_EPI) { wave_epilogue(L, w, lane, o, lsum, F.XN, tok0, tok0 + 64, h * 64); vb.issued(4); }
    }
    ATT_WAIT_BAR(0);
#undef ATT_ISSUE_TILE
#undef ATT_A_PIECE
}

__device__ __forceinline__ void decodeB(int ui, int& kvh, int& Ls, int& base, int& p0) {
    int seq, pb;
    if (ui < 1024) { seq = ui >> 7; kvh = (ui >> 6) & 1; pb = ui & 63; Ls = SEQ_P; base = seq * SEQ_P; }
    else { const int u2 = ui - 1024; seq = u2 >> 8; kvh = (u2 >> 7) & 1; pb = u2 & 127; Ls = SEQ_S; base = MP + seq * SEQ_S; }
    p0 = 64 * pb;
}
struct CursorB {
    int u, t, T; const bf16* pk; const bf16* pv;
    __device__ __forceinline__ void load_unit(const Frame& F, int klo, int vlo) {
        int kvh, Ls, base, p0; decodeB(u, kvh, Ls, base, p0);
        int t_lo = 0, t_hi = 5; if (p0 < 128) t_lo = (128 - p0) >> 6; if (p0 + 192 > Ls) t_hi = 5 - ((p0 + 192 - Ls) >> 6);
        t = t_lo; T = t_hi;
        const long tok = (long)base + p0 - 128 + 64 * t_lo;
        pk = F.KVB + tok * 256 + kvh * 64 + klo; pv = F.KVB + tok * 256 + 128 + kvh * 64 + vlo;
    }
    __device__ __forceinline__ void advance(const Frame& F, int klo, int vlo, int NU) {
        if (t + 1 < T) { ++t; pk += 64 * 256; pv += 64 * 256; }
        else if (u + F.G < NU) { u += F.G; load_unit(F, klo, vlo); }
    }
};

__device__ __forceinline__ void phase_B(Frame& F, LAS char* L) {
    const int lane = F.lane, w = F.wave, r32 = lane & 31, hi = lane >> 5;
    const int gq = w >> 1, half = w & 1;
    int koff[4];
#pragma unroll
    for (int d0 = 0; d0 < 4; ++d0) koff[d0] = r32 * 128 + (((2 * d0 + hi) ^ ((r32 >> 1) & 7)) << 4);
    const int voff = KB_BYTES + (4 * hi + ((lane & 15) >> 2)) * 64 + ((lane >> 4) & 1) * 32 + (lane & 3) * 8;
    const int krow = 8 * w + (lane >> 3), klo = krow * 256 + (((lane & 7) ^ ((krow >> 1) & 7)) << 3);
    const int vlo = (16 * (w & 3) + (lane >> 2)) * 256 + (w >> 2) * 32 + (lane & 3) * 8;
    const unsigned lds0 = (unsigned)(uintptr_t)L;
    const unsigned kdst = lds0 + L_KV + w * 1024, vdst = lds0 + L_KV + KB_BYTES + (w >> 2) * DHS + (w & 3) * 1024;
    const unsigned qdst = lds0 + L_Q + w * 4096, zdst = lds0 + L_ZO + w * 4096;
    const int qz_lane = (lane >> 3) * 512 + (lane & 7) * 8;
    const LAS float* t5L = (const LAS float*)(L + L_T5);
    const float M0b = ((const LAS float*)(L + L_RED))[48];
    const float sink_e0 = __builtin_amdgcn_exp2f(F.sink[gq] * pg8::LOG2E - M0b), sink_e1 = __builtin_amdgcn_exp2f(F.sink[4 + gq] * pg8::LOG2E - M0b);
    const f32x16 dummy = f32x16{};
    const int NU = 3072;
    CursorB cur; cur.u = F.vcu; cur.load_unit(F, klo, vlo);
#define ATT_B_PIECE(P, uu, dst, i) do { int kvh_, Ls_, base_, p0_; decodeB((uu), kvh_, Ls_, base_, p0_); \
        glds16((P) + (size_t)(base_ + p0_ + 32 * half + 8 * (i)) * 512 + (kvh_ * 4 + gq) * 64 + qz_lane, (unsigned)__builtin_amdgcn_readfirstlane((dst) + (i) * 1024)); } while (0)
    VmBook vb; vb.init();
#pragma unroll
    for (int i = 0; i < 4; ++i) ATT_B_PIECE(F.QB, F.vcu, qdst, i);
    vb.issued(4); vb.since_q = 0;
    bool more = true; int wslot = 0, rslot = 0;
#define ATT_ISSUE_TILE() do { ATT_DMA(cur, wslot); wslot = (wslot + 1) & (NS - 1); vb.issued(2); vb.since_pair = 0; \
        if (cur.t + 1 < cur.T) { ++cur.t; cur.pk += 64 * 256; cur.pv += 64 * 256; } else if (cur.u + F.G < NU) { cur.u += F.G; cur.load_unit(F, klo, vlo); } else { more = false; } } while (0)
    { const int np0 = (cur.T - cur.t >= 2) ? 2 : 1; ATT_ISSUE_TILE(); if (np0 == 2) ATT_ISSUE_TILE(); }
    for (int ui = F.vcu; ui < NU; ui += F.G) {
        int kvh, Ls, base, p0; decodeB(ui, kvh, Ls, base, p0);
        const int h = kvh * 4 + gq, pq = p0 + 32 * half, qpos = pq + r32;
        int t_lo = 0, t_hi = 5; if (p0 < 128) t_lo = (128 - p0) >> 6; if (p0 + 192 > Ls) t_hi = 5 - ((p0 + 192 - Ls) >> 6);
        f32x16 o[2]; o[0] = f32x16{}; o[1] = f32x16{}; float lsum = 0.f;
        bf16x8 qr[4];
        const int un = (ui + F.G < NU) ? ui + F.G : ui;
        int ss = 0;
        for (int t = t_lo; t < t_hi; ++ss) {
            const int n = (t_hi - t >= 2) ? 2 : 1;
            { int w_ = vb.since_pair; if (ss == 0 && vb.since_q < w_) w_ = vb.since_q; wait_bar(w_); }
            if (ss == 0) ATT_QFRAGS();
            const int np = more ? ((cur.T - cur.t >= 2) ? 2 : 1) : 0;
            if (np >= 1) ATT_ISSUE_TILE();
#pragma unroll
            for (int i = 0; i < 2; ++i) if (i < n) {
                const LAS char* buf = L + L_KV + ((rslot + i) & (NS - 1)) * BUF_BYTES;
                const LAS float* tab0 = t5L + (h * 384 + (p0 - 128 + 64 * (t + i)) - qpos + 192 + 4 * hi);
                subtile<false>(buf, koff, buf + voff, tab0, dummy, qr, o, lsum);
                if (i == 0 && np >= 2) ATT_ISSUE_TILE();
                subtile<false>(buf + 4096, koff, buf + voff + 2048, tab0 + 32, dummy, qr, o, lsum);
                if (i == 0) {
                    if (ss == 0) {
#pragma unroll
                        for (int k = 0; k < 4; ++k) ATT_B_PIECE(F.ZB, ui, zdst, k);
                        vb.issued(4); vb.since_z = 0; }
                    if (ss == 1) {
#pragma unroll
                        for (int k = 0; k < 4; ++k) ATT_B_PIECE(F.QB, un, qdst, k);
                        vb.issued(4); vb.since_q = 0; }
                }
            }
            rslot = (rslot + n) & (NS - 1); t += n;
        }
        { auto rr = __builtin_amdgcn_permlane32_swap(__float_as_uint(lsum), __float_as_uint(lsum), false, false); lsum = __uint_as_float(rr[0]) + __uint_as_float(rr[1]); }
        lsum += kvh ? sink_e1 : sink_e0;
        const int tok0 = base + pq;
        wait_vm(vb.since_z);
        wave_epilogue(L, w, lane, o, lsum, F.XN, tok0, tok0 + 16, 512 + h * 64); vb.issued(4);
    }
    ATT_WAIT_BAR(0);
#undef ATT_ISSUE_TILE
#undef ATT_B_PIECE
}
#undef ATT_DMA
#undef ATT_QFRAGS
}

#ifndef MK_N_LAUNCHES
#define MK_N_LAUNCHES 1
#endif
constexpr int N_PHASES = 5;
constexpr int N_LAUNCHES = MK_N_LAUNCHES;
struct Args { const float* in[14]; float* out; unsigned char* ws; int ph_lo, ph_hi; };
__global__ void __launch_bounds__(NWAVES * 64, 2) enc_fwd(Args args) {
    extern __shared__ __attribute__((aligned(16))) unsigned char lds[];
    Frame F;
    F.lds = (LAS unsigned char*)lds;
    F.MISC = (volatile LAS unsigned*)(F.lds + MISC_OFF);
    F.tid = threadIdx.x; F.lane = F.tid & 63; F.wave = __builtin_amdgcn_readfirstlane(F.tid >> 6);
    F.G = gridDim.x; { const int bx = blockIdx.x; F.vcu = (F.G % 8 == 0) ? (bx % 8) * (F.G / 8) + bx / 8 : bx; }
    unsigned char* ws = args.ws;
    F.ctl = (gu32*)(ws + WS_CTL);
    F.xp = args.in[0]; F.xs = args.in[1]; F.norm_g = args.in[2]; F.w_in = args.in[3]; F.qn_a = args.in[4]; F.kn_a = args.in[5]; F.rpb = args.in[6];
    F.qn_b = args.in[7]; F.kn_b = args.in[8]; F.sink = args.in[9]; F.w_o_a = args.in[10]; F.w_o_b = args.in[11]; F.w_out = args.in[12]; F.t5 = args.in[13];
    F.out = args.out;
    F.Win_t = (bf16*)(ws + WS_WIN); F.Wo_t = (bf16*)(ws + WS_WO); F.Wout_t = (bf16*)(ws + WS_WOUT);
    F.XN = (bf16*)(ws + WS_XN); F.QA = (bf16*)(ws + WS_QA); F.KA = (bf16*)(ws + WS_KA); F.VA = (bf16*)(ws + WS_VA); F.ZA = (bf16*)(ws + WS_ZA);
    F.QB = (bf16*)(ws + WS_QB); F.ZB = (bf16*)(ws + WS_ZB); F.KVB = (bf16*)(ws + WS_KVB); F.MRG = (bf16*)(ws + WS_MRG); F.XN8 = ws + WS_XN8; F.WG8 = ws + WS_WG8; F.RSC = (float*)(ws + WS_RSC); F.CS = (float*)(ws + WS_RSC + 512 * 1024);
    bf16* Gt = (bf16*)args.out;
    for (int u = F.tid; u < (LDS_BYTES - LDSCTL_OFF) / 4; u += NWAVES * 64) ((LAS unsigned*)(F.lds + LDSCTL_OFF))[u] = 0u;
    __syncthreads();
    XcdBarrier bar; bar.bar = (unsigned*)(F.ctl + CW_BAR); bar.x = 0; bar.st = nullptr;
    if (N_LAUNCHES == 1) bar = xcd_barrier_post((unsigned*)(F.ctl + CW_BAR), F.MISC + 8);
    const int lo = args.ph_lo, hi = args.ph_hi;
#define IN(k) (lo <= (k) && (k) < hi)
#define SEAM(k) do { if (IN(k) && IN((k) + 1)) xcd_barrier(bar); } while (0)

    if (IN(0)) { p0_prologue(F); SEAM(0); }
    if (IN(1)) {
        { pg8::Gemm g{(const bf16*)F.XN8, (const bf16*)F.WG8, 512, 512, 512}; pg8::StaticOrder S; S.init(M, NI8, F.G, (int)blockIdx.x);
          LAS float* csL = (LAS float*)(F.lds + RING_BYTES); LAS float* wL = csL + NI8;
          for (int i = F.tid; i < NI8; i += NWAVES * 64) csL[i] = F.CS[i];
          if (F.tid < 256) { const float* wsrc = (F.tid < 64) ? F.qn_a : (F.tid < 128) ? F.kn_a : (F.tid < 192) ? F.qn_b : F.kn_b; wL[F.tid] = wsrc[F.tid & 63]; }
          __syncthreads();
          pg8::EpiProjI8 E{F.QA, F.KA, F.VA, F.ZA, F.QB, F.KVB, F.ZB, (unsigned char*)Gt, wL, F.RSC, csL, wL + 256};
          pg8::gemm_phase<pg8::EpiProjI8, pg8::StaticOrder, true, true, true>(F.lds + RING_OFF, g, S, E); }
        SEAM(1);
    }
    if (IN(2)) {
#if defined(ATT_NAIVE)
        attn_naive_A(F); attn_naive_B(F);
#else
        LAS char* L = (LAS char*)(F.lds + RING_OFF);
        att::setup(F, L); att::phase_A(F, L); att::phase_B(F, L);
#endif
        SEAM(2);
    }
    if (IN(3)) {
        pg8::Gemm g{F.XN, F.Wo_t, DM, DM, 512}; pg8::StaticOrder S; S.init(M, DM, F.G, (int)blockIdx.x, 2);
        pg8::EpiMerge E{F.MRG, (const unsigned char*)Gt};
        pg8::gemm_phase<pg8::EpiMerge, pg8::StaticOrder, true, true>(F.lds + RING_OFF, g, S, E);
        SEAM(3);
    }
    if (IN(4)) {
        pg8::Gemm g{F.MRG, F.Wout_t, DM, DM, DM}; pg8::StaticOrder S; S.init(M, DM, F.G, (int)blockIdx.x);
        pg8::EpiOut E{F.xp, F.xs, F.out, MP};
        pg8::gemm_phase<pg8::EpiOut, pg8::StaticOrder, true, true>(F.lds + RING_OFF, g, S, E);
    }
#undef IN
#undef SEAM
}

extern "C" void kernel_launch(void* const* d_in, const int* in_sizes, int n_in, void* d_out, int out_size, void* d_ws, size_t ws_size, hipStream_t stream) {
    static int grid = 0;
    if (grid == 0) {
        if (n_in != 14 || in_sizes[0] != MP * DM || in_sizes[1] != MS * DM || out_size != M * DM || ws_size < WS_END) {
            fprintf(stderr, "kernel_launch: unexpected shapes: n_in %d in0 %d in1 %d out %d ws %zu (need %zu); nothing launched\n", n_in, n_in > 0 ? in_sizes[0] : -1, n_in > 1 ? in_sizes[1] : -1, out_size, ws_size, (size_t)WS_END); grid = -1; return; }
        int dev = 0, cus = 0, per_cu = 0;
        if (hipGetDevice(&dev) != hipSuccess || hipDeviceGetAttribute(&cus, hipDeviceAttributeMultiprocessorCount, dev) != hipSuccess) { fprintf(stderr, "kernel_launch: device query failed\n"); grid = -1; return; }
        if (hipFuncSetAttribute((const void*)enc_fwd, hipFuncAttributeMaxDynamicSharedMemorySize, LDS_BYTES) != hipSuccess) { fprintf(stderr, "kernel_launch: hipFuncSetAttribute failed\n"); grid = -1; return; }
        if (hipOccupancyMaxActiveBlocksPerMultiprocessor(&per_cu, (const void*)enc_fwd, NWAVES * 64, LDS_BYTES) != hipSuccess || per_cu < 1) {
            fprintf(stderr, "kernel_launch: occupancy query reports %d workgroups per CU; nothing launched\n", per_cu); (void)hipGetLastError(); grid = -1; return; }
        grid = cus;
    }
    if (grid < 0) return;
    if (hipMemsetAsync((char*)d_ws + WS_CTL, 0, CTL_ZERO_BYTES, stream) != hipSuccess) { fprintf(stderr, "kernel_launch: memset failed\n"); return; }
    Args a{};
    for (int i = 0; i < 14; ++i) a.in[i] = (const float*)d_in[i];
    a.out = (float*)d_out; a.ws = (unsigned char*)d_ws;
    if (N_LAUNCHES == 1) {
        a.ph_lo = 0; a.ph_hi = N_PHASES;
        void* kargs[] = {&a};
        hipError_t e = hipLaunchCooperativeKernel((const void*)enc_fwd, dim3(grid), dim3(NWAVES * 64), kargs, LDS_BYTES, stream);
        if (e != hipSuccess) fprintf(stderr, "kernel_launch: cooperative launch failed: %s (grid %d)\n", hipGetErrorString(e), grid);
    } else {
        for (int li = 0; li < N_PHASES; ++li) {
            a.ph_lo = li; a.ph_hi = li + 1;
            hipLaunchKernelGGL(enc_fwd, dim3(grid), dim3(NWAVES * 64), LDS_BYTES, stream, a);
        }
    }
}
```

```cpp
#include <hip/hip_runtime.h>
#include <cstdio>
#include <cstdint>
namespace pg8 {
#define PG8_LAS __attribute__((address_space(3)))
typedef unsigned short bf16_t;
typedef short bf16x8 __attribute__((ext_vector_type(8)));
typedef float f32x4 __attribute__((ext_vector_type(4)));
typedef unsigned u32x4 __attribute__((ext_vector_type(4)));
typedef int i32x4 __attribute__((ext_vector_type(4)));
constexpr int BM = 256, BK = 64, HALF = 128, HTB = HALF * BK * 2  , STAGE_BYTES = 8 * HTB, NXCD = 8, WGM = 8;

__host__ __device__ __forceinline__ int lds_byte(int r, int c) { const int st = (r >> 4) * 2 + (c >> 5), rr = r & 15, cc = c & 31, ob = rr * 64 + cc * 2; return st * 1024 + (ob ^ (((ob >> 9) & 1) << 5)); }
__host__ __device__ __forceinline__ void stage_rc(int b, int& R, int& C) { const int st = b / 1024, sb = b % 1024, swz = sb ^ (((sb >> 9) & 1) << 5); R = (st >> 1) * 16 + swz / 64; C = (st & 1) * 32 + (swz % 64) / 2; }
__host__ __device__ __forceinline__ int perm32(int rho) { const int n = rho >> 4, i = rho & 15; return 8 * (i >> 2) + 4 * n + (i & 3); }

struct Unit { int pm, pn, kh; };
struct Gemm { const bf16_t* A; const bf16_t* Bt; int lda, ldb, K; };

struct StaticOrder {
    int nM, nN, nwg, G, c, ks, rev = 0, glob = 0, rot = 0;
    __host__ __device__ void init(int M, int N, int G_, int c_, int ks_ = 1) { nM = M / BM; nN = N / BM; nwg = nM * nN; G = G_; c = c_; ks = ks_; }
    __host__ __device__ bool next(int i, Unit& u) const {
        const int it = (ks == 2) ? (i >> 1) : i; u.kh = (ks == 2) ? (i & 1) : 0;
        if ((long)it * G + c >= nwg) return false;
        if (glob) {
            const int r = rev ? (nwg / G - 1 - it) : it; u.pm = 64 * r + 8 * (c & 7) + ((c >> 3) & 7); u.pn = c >> 6; return true; }
        const long L = (long)(rev ? (nwg / G - 1 - it) : it) * G + c;
        int wgid = (int)L; { const int q = nwg / NXCD, r = nwg % NXCD, xcd = wgid % NXCD, off = wgid / NXCD; wgid = (xcd < r ? xcd * (q + 1) : r * (q + 1) + (xcd - r) * q) + off; }
        const int nig = WGM * nN, gid = wgid / nig, fm = gid * WGM, gsz = (nM - fm) < WGM ? (nM - fm) : WGM;
        u.pm = fm + ((wgid % nig) % gsz); u.pn = (wgid % nig) / gsz;
        if (rot) { const unsigned long long t = (u.pn < 12) ? 0x2c8911c04f0b80dull : 0xc5d14944ce6ull; u.pn = (int)((t >> (5 * (u.pn < 12 ? u.pn : u.pn - 12))) & 31u); }
        return true;
    }
    __device__ __forceinline__ void a_ready(const Unit&) const {}
    __device__ __forceinline__ void done(const Unit&) const {}
};

__device__ __forceinline__ unsigned cvt_pk_bf16(float lo, float hi) { unsigned r; asm volatile("v_cvt_pk_bf16_f32 %0, %1, %2" : "=v"(r) : "v"(lo), "v"(hi)); return r; }
__device__ __forceinline__ float bf_lo(unsigned w) { return __uint_as_float(w << 16); }
__device__ __forceinline__ float bf_hi(unsigned w) { return __uint_as_float(w & 0xffff0000u); }
__device__ __forceinline__ float sigmoidf_(float v) { return __builtin_amdgcn_rcpf(1.0f + __builtin_amdgcn_exp2f(-1.4426950408889634f * v)); }

constexpr float C2 = 0.125f * 1.4426950408889634f;
constexpr float LOG2E = 1.4426950408889634f;

__device__ __forceinline__ void swap8(u32x4& a, u32x4& b, bool  ) {
    unsigned a0, a1, a2, a3, b0, b1, b2, b3;
    asm volatile("s_nop 1\n\t"
                 "s_mov_b32 vcc_lo, 0xff00ff00\n\t"
                 "s_mov_b32 vcc_hi, 0xff00ff00\n\t"
                 "v_cndmask_b32_dpp %4, %8, %12, vcc row_ror:8 row_mask:0xf bank_mask:0xf\n\t"
                 "v_cndmask_b32_dpp %5, %9, %13, vcc row_ror:8 row_mask:0xf bank_mask:0xf\n\t"
                 "v_cndmask_b32_dpp %6, %10, %14, vcc row_ror:8 row_mask:0xf bank_mask:0xf\n\t"
                 "v_cndmask_b32_dpp %7, %11, %15, vcc row_ror:8 row_mask:0xf bank_mask:0xf\n\t"
                 "s_not_b64 vcc, vcc\n\t"
                 "v_cndmask_b32_dpp %0, %12, %8, vcc row_ror:8 row_mask:0xf bank_mask:0xf\n\t"
                 "v_cndmask_b32_dpp %1, %13, %9, vcc row_ror:8 row_mask:0xf bank_mask:0xf\n\t"
                 "v_cndmask_b32_dpp %2, %14, %10, vcc row_ror:8 row_mask:0xf bank_mask:0xf\n\t"
                 "v_cndmask_b32_dpp %3, %15, %11, vcc row_ror:8 row_mask:0xf bank_mask:0xf"
                 : "=&v"(a0), "=&v"(a1), "=&v"(a2), "=&v"(a3), "=&v"(b0), "=&v"(b1), "=&v"(b2), "=&v"(b3)
                 : "v"(a.x), "v"(a.y), "v"(a.z), "v"(a.w), "v"(b.x), "v"(b.y), "v"(b.z), "v"(b.w) : "vcc", "scc");
    a = (u32x4){a0, a1, a2, a3}; b = (u32x4){b0, b1, b2, b3};
}
__device__ __forceinline__ void swap8f(f32x4& a, f32x4& b, bool up) { u32x4 x = __builtin_bit_cast(u32x4, a), y = __builtin_bit_cast(u32x4, b); swap8(x, y, up); a = __builtin_bit_cast(f32x4, x); b = __builtin_bit_cast(f32x4, y); }

__device__ __forceinline__ void proj_rows(f32x4 (&v)[2][2], bool norm, float sc, const f32x4 (&wv)[2][2], bf16_t* rowp, size_t ld, bool up) {
    if (norm) {
        float ss = 0.f;
#pragma unroll
        for (int bj = 0; bj < 2; ++bj)
#pragma unroll
            for (int n = 0; n < 2; ++n) { const f32x4 x = v[bj][n]; ss += (x[0] * x[0] + x[1] * x[1]) + (x[2] * x[2] + x[3] * x[3]); }
        ss += __shfl_xor(ss, 16); ss += __shfl_xor(ss, 32);
        const float rs = __builtin_amdgcn_rsqf(ss * (1.0f / 64.0f) + 1e-6f) * sc;
#pragma unroll
        for (int bj = 0; bj < 2; ++bj)
#pragma unroll
            for (int n = 0; n < 2; ++n) v[bj][n] = v[bj][n] * rs * wv[bj][n];
    }
    u32x4 o0, o1;
    o0.x = cvt_pk_bf16(v[0][0][0], v[0][0][1]); o0.y = cvt_pk_bf16(v[0][0][2], v[0][0][3]); o0.z = cvt_pk_bf16(v[0][1][0], v[0][1][1]); o0.w = cvt_pk_bf16(v[0][1][2], v[0][1][3]);
    o1.x = cvt_pk_bf16(v[1][0][0], v[1][0][1]); o1.y = cvt_pk_bf16(v[1][0][2], v[1][0][3]); o1.z = cvt_pk_bf16(v[1][1][0], v[1][1][1]); o1.w = cvt_pk_bf16(v[1][1][2], v[1][1][3]);
    swap8(o0, o1, up);
    __builtin_nontemporal_store(o0, (u32x4*)rowp); __builtin_nontemporal_store(o1, (u32x4*)(rowp + (size_t)8 * ld));
}
struct EpiProjI8 {
    static constexpr bool PERM = true, AFTER_DRAIN = false;
    bf16_t *QA, *KA, *VA, *ZA, *QB, *KVB, *ZB; unsigned char* G8; const PG8_LAS float* wL; const float* rowscale; const PG8_LAS float* csL; PG8_LAS float* rsL;
    struct Pre {};
    __device__ __forceinline__ void preload(Pre&, const Unit& u, int wr, int wc, int fr, int fq) const {
        if (wr == 0 && wc == 0) __builtin_amdgcn_global_load_lds((const unsigned*)(rowscale + u.pm * BM + (fq * 16 + fr) * 4), (PG8_LAS unsigned*)rsL, 16, 0, 0);
    }
    __device__ __forceinline__ static float sum_fq(float x) {
        { auto rr = __builtin_amdgcn_permlane16_swap(__float_as_uint(x), __float_as_uint(x), false, false); x = __uint_as_float(rr[0]) + __uint_as_float(rr[1]); }
        { auto rr = __builtin_amdgcn_permlane32_swap(__float_as_uint(x), __float_as_uint(x), false, false); x = __uint_as_float(rr[0]) + __uint_as_float(rr[1]); }
        return x;
    }
    __device__ __forceinline__ void operator()(const f32x4 (&acc)[2][2][4][2], const Unit& u, int wr, int wc, int fr, int fq, const Pre&) const {
        const int pn = u.pn;
        const bool up = (fr & 8) != 0;
        float rs[8];
#pragma unroll
        for (int g = 0; g < 8; ++g) rs[g] = rsL[(g >> 2) * HALF + wr * 64 + (g & 3) * 16 + fr];
        f32x4 csv[2][2];
#pragma unroll
        for (int bj = 0; bj < 2; ++bj)
#pragma unroll
            for (int n = 0; n < 2; ++n) csv[bj][n] = *(const PG8_LAS f32x4*)(csL + pn * BM + wc * 64 + 32 * bj + 8 * fq + 4 * n);
        if (pn >= 13) {
            unsigned char* gp = G8 + (size_t)(u.pm * 8 + (pn - 13)) * 65536 + (size_t)(((wr * 4 + wc) * 64) + fq * 16 + fr) * 16;
#pragma unroll
            for (int bj = 0; bj < 2; ++bj)
#pragma unroll
                for (int n = 0; n < 2; ++n) csv[bj][n] = csv[bj][n] * -LOG2E;
#pragma unroll
            for (int g = 0; g < 8; ++g) {
                const float rsc = rs[g];
                u32x4 o;
#pragma unroll
                for (int bj = 0; bj < 2; ++bj)
#pragma unroll
                    for (int n = 0; n < 2; ++n) {
                        f32x4 x = __builtin_convertvector(__builtin_bit_cast(i32x4, acc[g >> 2][bj][g & 3][n]), f32x4) * (csv[bj][n] * rsc);
#pragma unroll
                        for (int i = 0; i < 4; ++i) x[i] = __builtin_amdgcn_exp2f(x[i]);
                        x = x * (1.0f / 255.0f) + (1.0f / 255.0f);
#pragma unroll
                        for (int i = 0; i < 4; ++i) x[i] = __builtin_amdgcn_rcpf(x[i]);
                        unsigned pk = __builtin_amdgcn_cvt_pk_u8_f32(x[0], 0u, 0u); pk = __builtin_amdgcn_cvt_pk_u8_f32(x[1], 1u, pk); pk = __builtin_amdgcn_cvt_pk_u8_f32(x[2], 2u, pk); pk = __builtin_amdgcn_cvt_pk_u8_f32(x[3], 3u, pk);
                        o[bj * 2 + n] = pk; }
                __builtin_nontemporal_store(o, (u32x4*)(gp + g * 8192));
            }
            return;
        }
        bf16_t* base; int ld = 512, coff; int w = 64; bool norm = false; float sc = 1.0f;
        if (pn < 2)        { base = QA;  coff = pn * 256;        norm = true; w = 0; sc = C2; }
        else if (pn < 4)   { base = KA;  coff = (pn - 2) * 256;  norm = true; w = 64; }
        else if (pn < 6)   { base = VA;  coff = (pn - 4) * 256; }
        else if (pn < 8)   { base = ZA;  coff = (pn - 6) * 256; }
        else if (pn < 10)  { base = QB;  coff = (pn - 8) * 256;  norm = true; w = 128; sc = C2; }
        else if (pn == 10) { base = KVB; ld = 256; coff = 0;     norm = wc < 2; w = 192; }
        else               { base = ZB;  coff = (pn - 11) * 256; }
        const int col0 = coff + wc * 64 + 8 * fq + (up ? 32 : 0);
        const size_t ldz = (size_t)ld;
        bf16_t* const p0 = base + (size_t)(u.pm * BM + wr * 64 + (fr & 7)) * ldz + col0;
        f32x4 wv[2][2];
#pragma unroll
        for (int bj = 0; bj < 2; ++bj)
#pragma unroll
            for (int n = 0; n < 2; ++n) wv[bj][n] = *(const PG8_LAS f32x4*)(wL + w + 32 * bj + 8 * fq + 4 * n) * sc;
#pragma unroll
        for (int g = 0; g < 8; ++g) {
            const float r = rs[g];
            f32x4 v[2][2];
            if (norm) {
#pragma unroll
                for (int bj = 0; bj < 2; ++bj)
#pragma unroll
                    for (int n = 0; n < 2; ++n) v[bj][n] = __builtin_convertvector(__builtin_bit_cast(i32x4, acc[g >> 2][bj][g & 3][n]), f32x4) * csv[bj][n];
                f32x4 s4 = v[0][0] * v[0][0];
                s4 = __builtin_elementwise_fma(v[0][1], v[0][1], s4); s4 = __builtin_elementwise_fma(v[1][0], v[1][0], s4); s4 = __builtin_elementwise_fma(v[1][1], v[1][1], s4);
                const float ss = sum_fq((s4[0] + s4[1]) + (s4[2] + s4[3]));
                const float f = r * __builtin_amdgcn_rsqf((r * r) * ss * (1.0f / 64.0f) + 1e-6f);
#pragma unroll
                for (int bj = 0; bj < 2; ++bj)
#pragma unroll
                    for (int n = 0; n < 2; ++n) v[bj][n] = v[bj][n] * (wv[bj][n] * f);
            } else {
#pragma unroll
                for (int bj = 0; bj < 2; ++bj)
#pragma unroll
                    for (int n = 0; n < 2; ++n) v[bj][n] = __builtin_convertvector(__builtin_bit_cast(i32x4, acc[g >> 2][bj][g & 3][n]), f32x4) * (csv[bj][n] * r);
            }
            u32x4 o0, o1;
            o0.x = cvt_pk_bf16(v[0][0][0], v[0][0][1]); o0.y = cvt_pk_bf16(v[0][0][2], v[0][0][3]); o0.z = cvt_pk_bf16(v[0][1][0], v[0][1][1]); o0.w = cvt_pk_bf16(v[0][1][2], v[0][1][3]);
            o1.x = cvt_pk_bf16(v[1][0][0], v[1][0][1]); o1.y = cvt_pk_bf16(v[1][0][2], v[1][0][3]); o1.z = cvt_pk_bf16(v[1][1][0], v[1][1][1]); o1.w = cvt_pk_bf16(v[1][1][2], v[1][1][3]);
            swap8(o0, o1, up);
            bf16_t* rowp = p0 + (size_t)((g >> 2) * HALF + (g & 3) * 16) * ldz;
            __builtin_nontemporal_store(o0, (u32x4*)rowp); __builtin_nontemporal_store(o1, (u32x4*)(rowp + 8 * ldz));
        }
    }
};

struct EpiMerge {
    static constexpr bool PERM = true, AFTER_DRAIN = false;
    bf16_t* U; const unsigned char* G8;
    static constexpr int KEEP = 6;
    struct Pre { u32x4 qb[KEEP]; };
    __device__ __forceinline__ void preload(Pre&, const Unit&, int, int, int, int) const {}
    __device__ __forceinline__ static f32x4 ub4(unsigned w) { return (f32x4){(float)(w & 255u), (float)((w >> 8) & 255u), (float)((w >> 16) & 255u), (float)(w >> 24)}; }
    __device__ __forceinline__ void mid(f32x4 (&acc)[2][2][4][2], const Unit& u, int wr, int wc, int fr, int fq, Pre& pre) const {
        const unsigned char* ga = G8 + (size_t)(u.pm * 8 + u.pn) * 65536 + (size_t)(((wr * 4 + wc) * 64) + fq * 16 + fr) * 16;
        const unsigned char* gb = ga + 4 * 65536;
        u32x4 qa = *(const u32x4*)ga, qb = *(const u32x4*)gb;
#pragma unroll
        for (int c = 0; c < 8; ++c) {
            const u32x4 ca = qa, cb = qb; if (c < KEEP) pre.qb[c] = cb;
            if (c + 1 < 8) { qa = *(const u32x4*)(ga + (c + 1) * 8192); qb = *(const u32x4*)(gb + (c + 1) * 8192); }
#pragma unroll
            for (int bj = 0; bj < 2; ++bj)
#pragma unroll
                for (int n = 0; n < 2; ++n) { const f32x4 a = ub4(ca[bj * 2 + n]) + 0.5f; f32x4 b = ub4(cb[bj * 2 + n]) + 0.5f;
#pragma unroll
                    for (int i = 0; i < 4; ++i) b[i] = __builtin_amdgcn_rcpf(b[i]);
                    acc[c >> 2][bj][c & 3][n] = acc[c >> 2][bj][c & 3][n] * (a * b); }
        }
    }
    __device__ __forceinline__ void operator()(f32x4 (&acc)[2][2][4][2], const Unit& u, int wr, int wc, int fr, int fq, Pre& pre) const {
        if (u.kh == 0) { mid(acc, u, wr, wc, fr, fq, pre); return; }
        const bool up = (fr & 8) != 0;
        const int col0 = u.pn * BM + wc * 64 + 8 * fq + (up ? 32 : 0);
        const size_t rowb = (size_t)(u.pm * BM + wr * 64 + (fr & 7));
        const unsigned char* gb = G8 + (size_t)(u.pm * 8 + 4 + u.pn) * 65536 + (size_t)(((wr * 4 + wc) * 64) + fq * 16 + fr) * 16;
        u32x4 qb[8];
#pragma unroll
        for (int c = KEEP; c < 8; ++c) qb[c] = *(const u32x4*)(gb + c * 8192);
#pragma unroll
        for (int c = 0; c < KEEP; ++c) qb[c] = pre.qb[c];
#pragma unroll
        for (int ai = 0; ai < 2; ++ai)
#pragma unroll
            for (int m = 0; m < 4; ++m) {
                f32x4 v[2][2];
#pragma unroll
                for (int bj = 0; bj < 2; ++bj)
#pragma unroll
                    for (int n = 0; n < 2; ++n) v[bj][n] = acc[ai][bj][m][n] * (ub4(qb[ai * 4 + m][bj * 2 + n]) * (1.0f / 255.0f) + (0.5f / 255.0f));
                u32x4 o0, o1;
                o0.x = cvt_pk_bf16(v[0][0][0], v[0][0][1]); o0.y = cvt_pk_bf16(v[0][0][2], v[0][0][3]); o0.z = cvt_pk_bf16(v[0][1][0], v[0][1][1]); o0.w = cvt_pk_bf16(v[0][1][2], v[0][1][3]);
                o1.x = cvt_pk_bf16(v[1][0][0], v[1][0][1]); o1.y = cvt_pk_bf16(v[1][0][2], v[1][0][3]); o1.z = cvt_pk_bf16(v[1][1][0], v[1][1][1]); o1.w = cvt_pk_bf16(v[1][1][2], v[1][1][3]);
                swap8(o0, o1, up);
                bf16_t* rowp = U + (rowb + ai * HALF + m * 16) * 1024 + col0;
                *(u32x4*)rowp = o0; *(u32x4*)(rowp + (size_t)8 * 1024) = o1;
            }
    }
};

struct EpiOut {
    static constexpr bool PERM = true, AFTER_DRAIN = false;
    const float* xp; const float* xs; float* out; int MP;
    struct Pre {}; __device__ __forceinline__ void preload(Pre&, const Unit&, int, int, int, int) const {}
    __device__ __forceinline__ void operator()(const f32x4 (&acc)[2][2][4][2], const Unit& u, int wr, int wc, int fr, int fq, const Pre&) const {
        const bool up = (fr & 8) != 0;
        const int col0 = u.pn * BM + wc * 64 + 8 * fq + (up ? 4 : 0); const int r0 = u.pm * BM;
        const float* __restrict__ xb = ((r0 < MP) ? xp + (size_t)r0 * 1024 : xs + (size_t)(r0 - MP) * 1024) + (size_t)(wr * 64 + (fr & 7)) * 1024 + col0;
        float* __restrict__ ob = out + (size_t)r0 * 1024 + (size_t)(wr * 64 + (fr & 7)) * 1024 + col0;
        f32x4 xv[8][2][2];
#define EO_LOAD(g) do { _Pragma("unroll") for (int bj = 0; bj < 2; ++bj) _Pragma("unroll") for (int h = 0; h < 2; ++h) \
            xv[g][bj][h] = *(const f32x4*)(xb + (size_t)(((g) >> 2) * HALF + ((g) & 3) * 16 + 8 * h) * 1024 + 32 * bj); } while (0)
        EO_LOAD(0); EO_LOAD(1); EO_LOAD(2);
#pragma unroll
        for (int g = 0; g < 8; ++g) {
            if (g + 3 < 8) EO_LOAD(g + 3);
#pragma unroll
            for (int bj = 0; bj < 2; ++bj) { f32x4 a = acc[g >> 2][bj][g & 3][0], b = acc[g >> 2][bj][g & 3][1]; swap8f(a, b, up);
                *(f32x4*)(ob + (size_t)((g >> 2) * HALF + (g & 3) * 16) * 1024 + 32 * bj) = xv[g][bj][0] + a;
                *(f32x4*)(ob + (size_t)((g >> 2) * HALF + (g & 3) * 16 + 8) * 1024 + 32 * bj) = xv[g][bj][1] + b; }
        }
#undef EO_LOAD
    }
};

template <class Epi, class Sched, bool ALIGN_EPI = false, bool SP2 = false, bool I8 = false>
__device__ __forceinline__ void gemm_phase(PG8_LAS unsigned char* lds, const Gemm g, const Sched& S, const Epi& E) {
    const int tid = threadIdx.x, wid = __builtin_amdgcn_readfirstlane(tid >> 6), lane = tid & 63, wr = wid >> 2, wc = wid & 3, fr = lane & 15, fq = lane >> 4;
    const int K = g.K, nt = K / BK;
    unsigned voffA[2], voffB[2];
#pragma unroll
    for (int i = 0; i < 2; ++i) { int R, C; stage_rc(tid * 16 + i * 8192, R, C); const int Rb = Epi::PERM ? ((R & ~31) + perm32(R & 31)) : R;
        voffA[i] = (unsigned)(R * g.lda + C) * 2u; voffB[i] = (unsigned)(Rb * g.ldb + C) * 2u; }
    const size_t kstep = (size_t)(BK * 2);
    const size_t hstepA = (size_t)HALF * g.lda * 2, hstepB = (size_t)HALF * g.ldb * 2;
    const size_t tstepA = 2 * hstepA, tstepB = 2 * hstepB;
    const unsigned ldsw = (unsigned)wid * 1024u;
    const int aoff = lds_byte(wr * 64 + fr, fq * 8), boff = lds_byte(wc * 32 + fr, fq * 8);
#define PG8_SA(b, h) (((b) * 2 + (h)) * HTB)
#define PG8_SB(b, h) ((4 + (b) * 2 + (h)) * HTB)
#define PG8_STAGE(bufoff, gbase, voff) do { _Pragma("unroll") for (int _i = 0; _i < 2; ++_i) \
        __builtin_amdgcn_global_load_lds((const unsigned*)((const char*)(gbase) + (voff)[_i]), (PG8_LAS unsigned*)(lds + (bufoff) + ldsw + _i * 8192), 16, 0, 0); } while (0)
#define PG8_LDA(dst, b, h) do { _Pragma("unroll") for (int m = 0; m < 4; ++m) _Pragma("unroll") for (int k = 0; k < 2; ++k) dst[m][k] = *(const PG8_LAS bf16x8*)(lds + PG8_SA(b, h) + aoff + m * 2048 + k * 1024); } while (0)
#define PG8_LDB(dst, b, h) do { _Pragma("unroll") for (int n = 0; n < 2; ++n) _Pragma("unroll") for (int k = 0; k < 2; ++k) dst[n][k] = *(const PG8_LAS bf16x8*)(lds + PG8_SB(b, h) + boff + n * 2048 + k * 1024); } while (0)
#define PG8_MMA(ai, bj, At, Bt) do { __builtin_amdgcn_s_setprio(1); _Pragma("unroll") for (int m = 0; m < 4; ++m) _Pragma("unroll") for (int n = 0; n < 2; ++n) _Pragma("unroll") for (int k = 0; k < 2; ++k) \
        { if constexpr (I8) acc[ai][bj][m][n] = __builtin_bit_cast(f32x4, __builtin_amdgcn_mfma_i32_16x16x64_i8(__builtin_bit_cast(i32x4, Bt[n][k]), __builtin_bit_cast(i32x4, At[m][k]), __builtin_bit_cast(i32x4, acc[ai][bj][m][n]), 0, 0, 0)); \
          else acc[ai][bj][m][n] = __builtin_amdgcn_mfma_f32_16x16x32_bf16(Bt[n][k], At[m][k], acc[ai][bj][m][n], 0, 0, 0); } __builtin_amdgcn_s_setprio(0); } while (0)
#define PG8_WAIT_V(n) asm volatile("s_waitcnt vmcnt(" #n ")" ::: "memory")
#define PG8_WAIT_L(n) asm volatile("s_waitcnt lgkmcnt(" #n ")" ::: "memory")
#define PG8_BAR __builtin_amdgcn_s_barrier()
#define PG8_SCHED __builtin_amdgcn_sched_barrier(0)
    Unit cur, nxt; int ui = 0;
    if (!S.next(0, cur)) return;
    typename Epi::Pre pre;
    f32x4 acc[2][2][4][2];
#pragma unroll
    for (int a = 0; a < 2; ++a)
#pragma unroll
        for (int b = 0; b < 2; ++b)
#pragma unroll
            for (int m = 0; m < 4; ++m)
#pragma unroll
                for (int n = 0; n < 2; ++n) acc[a][b][m][n] = (f32x4){0.f, 0.f, 0.f, 0.f};
    bf16x8 At[4][2], B0[2][2], B1[2][2];
    const size_t khstep = (size_t)K * 2;
    const char* cA = (const char*)g.A + (size_t)cur.pm * tstepA + cur.kh * khstep; const char* cB = (const char*)g.Bt + (size_t)cur.pn * tstepB + cur.kh * khstep;
    S.a_ready(cur);
    if constexpr (SP2) {
        PG8_STAGE(PG8_SB(0, 0), cB, voffB); PG8_STAGE(PG8_SB(0, 1), cB + hstepB, voffB); PG8_STAGE(PG8_SA(0, 0), cA, voffA); PG8_STAGE(PG8_SA(0, 1), cA + hstepA, voffA);
        if (wr == 1) PG8_BAR;
        PG8_WAIT_V(2); PG8_BAR;
        PG8_STAGE(PG8_SB(1, 0), cB + kstep, voffB); PG8_STAGE(PG8_SA(1, 0), cA + kstep, voffA); PG8_STAGE(PG8_SB(1, 1), cB + hstepB + kstep, voffB);
        PG8_WAIT_V(6); PG8_BAR;
    } else {
        PG8_STAGE(PG8_SB(0, 0), cB, voffB); PG8_STAGE(PG8_SA(0, 0), cA, voffA); PG8_STAGE(PG8_SB(0, 1), cB + hstepB, voffB); PG8_STAGE(PG8_SA(0, 1), cA + hstepA, voffA);
        if (wr == 1) PG8_BAR;
        PG8_WAIT_V(4); PG8_BAR;
        PG8_STAGE(PG8_SB(1, 0), cB + kstep, voffB); PG8_STAGE(PG8_SA(1, 0), cA + kstep, voffA); PG8_STAGE(PG8_SB(1, 1), cB + hstepB + kstep, voffB);
        PG8_WAIT_V(6); PG8_BAR;
    }
    for (;;) {
        const bool has_next = S.next(ui + 1, nxt);
        const char* nA = has_next ? (const char*)g.A + (size_t)nxt.pm * tstepA + nxt.kh * khstep : cA; const char* nB = has_next ? (const char*)g.Bt + (size_t)nxt.pn * tstepB + nxt.kh * khstep : cB;
        for (int t = 0; t < nt; t += 2) {
            const bool last = (t == nt - 2);
            const char* a1 = cA + (size_t)(t + 1) * kstep;
            const char* a2 = last ? nA : cA + (size_t)(t + 2) * kstep; const char* b2 = last ? nB : cB + (size_t)(t + 2) * kstep;
            const char* a3 = a2 + kstep; const char* b3 = b2 + kstep;
            if (last && has_next) S.a_ready(nxt);
            if (last) E.preload(pre, cur, wr, wc, fr, fq);
            if constexpr (SP2) {
            PG8_LDB(B0, 0, 0); PG8_LDB(B1, 0, 1); PG8_SCHED; PG8_LDA(At, 0, 0); PG8_STAGE(PG8_SA(1, 1), a1 + hstepA, voffA);
            PG8_WAIT_V(8); PG8_WAIT_L(0); PG8_BAR; PG8_MMA(0, 0, At, B0); PG8_MMA(0, 1, At, B1); PG8_BAR; PG8_SCHED;
            PG8_LDA(At, 0, 1); PG8_STAGE(PG8_SB(0, 0), b2, voffB); PG8_STAGE(PG8_SB(0, 1), b2 + hstepB, voffB); PG8_STAGE(PG8_SA(0, 0), a2, voffA);
            PG8_WAIT_V(8); PG8_WAIT_L(0); PG8_BAR; PG8_MMA(1, 0, At, B0); PG8_MMA(1, 1, At, B1); PG8_BAR; PG8_SCHED;
            PG8_LDB(B0, 1, 0); PG8_LDB(B1, 1, 1); PG8_SCHED; PG8_LDA(At, 1, 0); PG8_STAGE(PG8_SA(0, 1), a2 + hstepA, voffA);
            PG8_WAIT_V(8); PG8_WAIT_L(0); PG8_BAR; PG8_MMA(0, 0, At, B0); PG8_MMA(0, 1, At, B1); PG8_BAR; PG8_SCHED;
            PG8_LDA(At, 1, 1); PG8_STAGE(PG8_SB(1, 0), b3, voffB); PG8_STAGE(PG8_SB(1, 1), b3 + hstepB, voffB); PG8_STAGE(PG8_SA(1, 0), a3, voffA);
            PG8_WAIT_V(8); PG8_WAIT_L(0); PG8_BAR; PG8_MMA(1, 0, At, B0); PG8_MMA(1, 1, At, B1); PG8_BAR; PG8_SCHED;
            } else {
            PG8_LDB(B0, 0, 0); PG8_SCHED; PG8_LDA(At, 0, 0); PG8_STAGE(PG8_SA(1, 1), a1 + hstepA, voffA);
            PG8_WAIT_L(8); PG8_BAR; PG8_WAIT_L(0); PG8_MMA(0, 0, At, B0); PG8_BAR; PG8_SCHED;
            PG8_LDB(B1, 0, 1); PG8_STAGE(PG8_SB(0, 0), b2, voffB);
            PG8_BAR; PG8_WAIT_L(0); PG8_MMA(0, 1, At, B1); PG8_BAR;
            PG8_LDA(At, 0, 1); PG8_STAGE(PG8_SA(0, 0), a2, voffA);
            PG8_BAR; PG8_WAIT_L(0); PG8_MMA(1, 0, At, B0); PG8_BAR; PG8_SCHED;
            PG8_STAGE(PG8_SB(0, 1), b2 + hstepB, voffB);
            PG8_WAIT_V(6); PG8_BAR; PG8_MMA(1, 1, At, B1); PG8_BAR;
            PG8_LDB(B0, 1, 0); PG8_SCHED; PG8_LDA(At, 1, 0); PG8_STAGE(PG8_SA(0, 1), a2 + hstepA, voffA);
            PG8_WAIT_L(8); PG8_BAR; PG8_WAIT_L(0); PG8_MMA(0, 0, At, B0); PG8_BAR; PG8_SCHED;
            PG8_LDB(B1, 1, 1); PG8_STAGE(PG8_SB(1, 0), b3, voffB);
            PG8_BAR; PG8_WAIT_L(0); PG8_MMA(0, 1, At, B1); PG8_BAR;
            PG8_LDA(At, 1, 1); PG8_STAGE(PG8_SA(1, 0), a3, voffA);
            PG8_BAR; PG8_WAIT_L(0); PG8_MMA(1, 0, At, B0); PG8_BAR; PG8_SCHED;
            PG8_STAGE(PG8_SB(1, 1), b3 + hstepB, voffB);
            PG8_WAIT_V(6); PG8_BAR; PG8_MMA(1, 1, At, B1); PG8_BAR;
            }
        }
        if constexpr (ALIGN_EPI) { if (wr == 0) PG8_BAR; }
        if constexpr (!Epi::AFTER_DRAIN) { E(acc, cur, wr, wc, fr, fq, pre); S.done(cur); }
        if (!has_next) break;
        if (nxt.kh == 0) {
#pragma unroll
        for (int a = 0; a < 2; ++a)
#pragma unroll
            for (int b = 0; b < 2; ++b)
#pragma unroll
                for (int m = 0; m < 4; ++m)
#pragma unroll
                    for (int n = 0; n < 2; ++n) acc[a][b][m][n] = (f32x4){0.f, 0.f, 0.f, 0.f};
        }
        cur = nxt; cA = nA; cB = nB; ++ui;
        if constexpr (ALIGN_EPI) { if (wr == 1) PG8_BAR; }
    }
    PG8_WAIT_V(0);
    if constexpr (!ALIGN_EPI) { if (wr == 0) PG8_BAR; }
    PG8_BAR;
    if constexpr (Epi::AFTER_DRAIN) { E.fused(acc, cur, wr, wc, fr, fq, lds, wid, lane); S.done(cur); }
#undef PG8_SA
#undef PG8_SB
#undef PG8_STAGE
#undef PG8_LDA
#undef PG8_LDB
#undef PG8_MMA
#undef PG8_WAIT_V
#undef PG8_WAIT_L
#undef PG8_BAR
#undef PG8_SCHED
}
}

constexpr int NWAVES = 8;
constexpr int DM = 1024, DIN = 5376, SEQ_P = 4096, SEQ_S = 8192, NB = 8;
constexpr int MP = NB * SEQ_P, MS = NB * SEQ_S, M = MP + MS;
constexpr size_t MiB = 1u << 20;
constexpr size_t WS_CTL = 0, CTL_ZERO_BYTES = 32768;
constexpr size_t WS_WIN = 2 * MiB, WS_WO = 13 * MiB, WS_WOUT = 15 * MiB;
constexpr size_t WS_XN = 32 * MiB;
constexpr size_t WS_QA = 224 * MiB, WS_KA = 320 * MiB, WS_VA = 416 * MiB, WS_ZA = 512 * MiB, WS_QB = 608 * MiB, WS_ZB = 704 * MiB, WS_KVB = 800 * MiB;
constexpr size_t WS_MRG = WS_QA;
constexpr size_t WS_XN8 = 848 * MiB, WS_RSC = 944 * MiB, WS_WG8 = 946 * MiB;
constexpr size_t WS_END = 952 * MiB;
constexpr int NBF = 0, NI8 = 5376;
constexpr int CW_CMAX = 8192;
constexpr int CW_BAR = 4096;
constexpr int RING_OFF = 0, RING_BYTES = 131072, LDS_BYTES = 163840, LDSCTL_OFF = LDS_BYTES - 1024, MISC_OFF = LDSCTL_OFF + 320, ATT_LDS_BYTES = LDSCTL_OFF;

#define GAS __attribute__((address_space(1)))
#define LAS __attribute__((address_space(3)))
typedef unsigned short bf16;
typedef unsigned v4u __attribute__((ext_vector_type(4)));
typedef float f32x4 __attribute__((ext_vector_type(4)));
typedef GAS unsigned gu32;
#define LDS_WAIT() asm volatile("s_waitcnt lgkmcnt(0)" ::: "memory")
#define VM_WAIT() asm volatile("s_waitcnt vmcnt(0)" ::: "memory")
__device__ __forceinline__ unsigned f2bf(float f) { unsigned u = __builtin_bit_cast(unsigned, f); return (u + 0x7fffu + ((u >> 16) & 1u)) >> 16; }
__device__ __forceinline__ unsigned pk2(float lo, float hi) { return f2bf(lo) | (f2bf(hi) << 16); }
__device__ __forceinline__ float bf2f(unsigned short b) { return __uint_as_float((unsigned)b << 16); }

#define XB_TMO      128
#define XB_XCNT(j)  (256  + 64 * (j))
#define XB_XSUB(j)  (1280 + 64 * (j))
#define XB_XGEN(j)  (2304 + 64 * (j))
#define XB_TOP      3328
#define XB_TOPGEN   3392
#define XCD_BAR_WORDS 3456
static_assert((size_t)(CW_BAR + XCD_BAR_WORDS) * 4 <= CTL_ZERO_BYTES, "the per-call memset covers the barrier words");
#define XB_SPIN_CAP (1u << 18)

__device__ __forceinline__ unsigned xb_ld(unsigned* p)              { return __hip_atomic_load(p, __ATOMIC_RELAXED, __HIP_MEMORY_SCOPE_AGENT); }
__device__ __forceinline__ unsigned xb_add(unsigned* p, unsigned v) { return __hip_atomic_fetch_add(p, v, __ATOMIC_RELAXED, __HIP_MEMORY_SCOPE_AGENT); }
__device__ __forceinline__ unsigned xb_xcc_id() { return (unsigned)__builtin_amdgcn_s_getreg((3 << 11) | 20) & 0xFu; }
#define XB_SPIN(cond, bar) do { unsigned _sp = 0; while (cond) { __builtin_amdgcn_s_sleep(1); \
    if ((++_sp & 255u) == 0u) { if (xb_ld(&(bar)[XB_TMO])) break; if (_sp > XB_SPIN_CAP) { atomicAdd(&(bar)[XB_TMO], 1u); break; } } } } while (0)

struct XcdBarrier {
    unsigned* bar; unsigned x;
    volatile LAS unsigned* st;
};

__device__ __forceinline__ XcdBarrier xcd_barrier_post(unsigned* bar, volatile LAS unsigned* st) {
    XcdBarrier b; b.bar = bar; b.x = xb_xcc_id(); b.st = st;
    if (threadIdx.x == 0) (void)xb_add(&bar[XB_XCNT(b.x)], 1u);
    return b;
}
__device__ __forceinline__ void xcd_barrier_complete(unsigned* bar, unsigned x, unsigned& nloc, unsigned& nx) {
    const unsigned G = gridDim.x * gridDim.y * gridDim.z;
    unsigned sum, cnt, mine, sp = 0u;
    for (;;) {
        sum = 0u; cnt = 0u; mine = 0u;
#pragma unroll
        for (unsigned j = 0; j < 16; ++j) { const unsigned c = xb_ld(&bar[XB_XCNT(j)]); sum += c; cnt += (c > 0u) ? 1u : 0u; mine = (j == x) ? c : mine; }
        if (sum == G) break;
        __builtin_amdgcn_s_sleep(1);
        if ((++sp & 255u) == 0u) { if (xb_ld(&bar[XB_TMO])) break; if (sp > XB_SPIN_CAP) { atomicAdd(&bar[XB_TMO], 1u); break; } }
    }
    nloc = mine > 0u ? mine : 1u; nx = cnt > 0u ? cnt : 1u;
}

__device__ __forceinline__ void xcd_barrier(const XcdBarrier& b) {
    asm volatile("s_waitcnt vmcnt(0)" ::: "memory");
    __syncthreads();
    if (threadIdx.x == 0) {
        unsigned* bar = b.bar;
        __builtin_amdgcn_s_waitcnt(0);
        unsigned nloc = b.st[0], nx = b.st[1];
        if (nloc == 0u) { xcd_barrier_complete(bar, b.x, nloc, nx); b.st[0] = nloc; b.st[1] = nx; }
        const unsigned old = xb_add(&bar[XB_XSUB(b.x)], 1u);
        const unsigned gen = old / nloc;
        if (old + 1u == (gen + 1u) * nloc) {
            __builtin_amdgcn_fence(__ATOMIC_RELEASE, "agent");
            asm volatile("s_waitcnt vmcnt(0)" ::: "memory");
            const unsigned og = xb_add(&bar[XB_TOP], 1u);
            const unsigned tg = og / nx;
            if (og + 1u == (tg + 1u) * nx) xb_add(&bar[XB_TOPGEN], 1u);
            else XB_SPIN(xb_ld(&bar[XB_TOPGEN]) == tg, bar);
            __builtin_amdgcn_fence(__ATOMIC_ACQUIRE, "agent");
            xb_add(&bar[XB_XGEN(b.x)], 1u);
            asm volatile("s_waitcnt vmcnt(0)" ::: "memory");
        } else {
            XB_SPIN(xb_ld(&bar[XB_XGEN(b.x)]) == gen, bar);
            __builtin_amdgcn_fence(__ATOMIC_ACQUIRE, "agent");
            asm volatile("s_waitcnt vmcnt(0)" ::: "memory");
        }
    }
    __syncthreads();
}


struct Frame {
    LAS unsigned char* lds; volatile LAS unsigned* MISC; gu32* ctl;
    int tid, lane, wave, vcu, G;
    const float *xp, *xs, *norm_g, *w_in, *qn_a, *kn_a, *rpb, *qn_b, *kn_b, *sink, *w_o_a, *w_o_b, *w_out, *t5; float* out;
    bf16 *Win_t, *Wo_t, *Wout_t, *XN, *QA, *KA, *VA, *ZA, *QB, *ZB, *KVB, *MRG; unsigned char *XN8, *WG8; float *RSC, *CS;
};
__device__ __forceinline__ float wave_sum(float v) {
#pragma unroll
    for (int o = 1; o < 64; o <<= 1) v += __shfl_xor(v, o);
    return v;
}
__device__ __forceinline__ float wave_max(float v) {
#pragma unroll
    for (int o = 1; o < 64; o <<= 1) v = fmaxf(v, __shfl_xor(v, o));
    return v;
}
__host__ __device__ __forceinline__ int colperm(int cs) { return (cs & ~255) | (((cs >> 5) & 1) << 7) | (((cs >> 6) & 3) << 5) | (cs & 31); }
__device__ __forceinline__ int src_col_bf(int nb) { const int t = nb >> 3; return (t < 2 ? 256 * t : 2048 + 256 * (t - 2)) + 32 * (nb & 7); }
__device__ __forceinline__ int src_col_i8(int nb) { return 32 * nb; }
template <int MAP> __device__ __forceinline__ int src_col(int c0, int nb) { return MAP == 0 ? c0 + 32 * nb : (MAP == 1 ? src_col_bf(nb) : src_col_i8(nb)); }
template <int MAP>
__device__ __forceinline__ void p0_transpose_item(const float* W, int ldw, int c0, int ncb, bf16* WT, int ldk, int koff, LAS float* scr, int item, int lane) {
    const int kb = item / ncb, nb = item % ncb, k0 = 64 * kb, n0 = 32 * nb; c0 = src_col<MAP>(c0, nb) - n0;
#pragma unroll 8
    for (int i = 0; i < 32; ++i) { const int kk = 2 * i + (lane >> 5); scr[kk * 33 + (lane & 31)] = W[(size_t)(k0 + kk) * ldw + c0 + n0 + (lane & 31)]; }
    LDS_WAIT(); asm volatile("" ::: "memory");
    const int c = lane & 7;
#pragma unroll
    for (int j = 0; j < 4; ++j) { const int n = (lane >> 3) + 8 * j; const LAS float* s = scr + (8 * c) * 33 + n;
        v4u o; o.x = pk2(s[0 * 33], s[1 * 33]); o.y = pk2(s[2 * 33], s[3 * 33]); o.z = pk2(s[4 * 33], s[5 * 33]); o.w = pk2(s[6 * 33], s[7 * 33]);
        *(GAS v4u*)(WT + (size_t)colperm(n0 + n) * ldk + koff + k0 + 8 * c) = o; }
    LDS_WAIT(); asm volatile("" ::: "memory");
}
__device__ __forceinline__ void p0_quant_block(const float* W, int ldw, int nb, unsigned char* W8, float* cs, LAS float* scr, LAS float* red, int wave, int lane) {
    const int n0 = 32 * nb, kw = 128 * wave;
    float mx = 0.f;
#pragma unroll 8
    for (int i = 0; i < 64; ++i) { const int kk = kw + 2 * i + (lane >> 5); mx = fmaxf(mx, fabsf(W[(size_t)kk * ldw + n0 + (lane & 31)])); }
    mx = fmaxf(mx, __shfl_xor(mx, 32));
    if (lane < 32) red[wave * 32 + lane] = mx;
    __syncthreads();
    const int c = lane & 7;
    float cmx[4];
#pragma unroll
    for (int j = 0; j < 4; ++j) { const int n = (lane >> 3) + 8 * j; float m = 0.f;
#pragma unroll
        for (int w = 0; w < NWAVES; ++w) m = fmaxf(m, red[w * 32 + n]);
        cmx[j] = fmaxf(m, 1e-30f); if (wave == 0 && c == 0) cs[n0 + n] = cmx[j] * (1.0f / 127.0f); }
#pragma unroll
    for (int hk = 0; hk < 2; ++hk) {
        const int k0 = kw + 64 * hk;
#pragma unroll 8
        for (int i = 0; i < 32; ++i) { const int kk = 2 * i + (lane >> 5); scr[kk * 33 + (lane & 31)] = W[(size_t)(k0 + kk) * ldw + n0 + (lane & 31)]; }
        LDS_WAIT(); asm volatile("" ::: "memory");
#pragma unroll
        for (int j = 0; j < 4; ++j) { const int n = (lane >> 3) + 8 * j; const LAS float* s = scr + (8 * c) * 33 + n; const float qs = 127.0f / cmx[j];
            unsigned lo = 0u, hi = 0u;
#pragma unroll
            for (int e = 0; e < 4; ++e) { lo |= ((unsigned)(int)rintf(s[e * 33] * qs) & 255u) << (8 * e); hi |= ((unsigned)(int)rintf(s[(4 + e) * 33] * qs) & 255u) << (8 * e); }
            *(GAS unsigned long long*)(W8 + (size_t)colperm(n0 + n) * 1024 + k0 + 8 * c) = (unsigned long long)lo | ((unsigned long long)hi << 32); }
        LDS_WAIT(); asm volatile("" ::: "memory");
    }
    __syncthreads();
}
#define WRED_STEP(OP, x, ctrl) x = OP(x, __int_as_float(__builtin_amdgcn_update_dpp(0, __float_as_int(x), ctrl, 0xf, 0xf, false)))
#define WRED_SWAP(OP, x, which) do { auto rr_ = __builtin_amdgcn_permlane##which##_swap(__float_as_uint(x), __float_as_uint(x), false, false); x = OP(__uint_as_float(rr_[0]), __uint_as_float(rr_[1])); } while (0)
__device__ __forceinline__ float wr_add(float a, float b) { return a + b; }
__device__ __forceinline__ float wr_max(float a, float b) { return fmaxf(a, b); }
__device__ __forceinline__ float wave_sum_dpp(float x) { WRED_STEP(wr_add, x, 0xB1); WRED_STEP(wr_add, x, 0x4E); WRED_STEP(wr_add, x, 0x124); WRED_STEP(wr_add, x, 0x128); WRED_SWAP(wr_add, x, 16); WRED_SWAP(wr_add, x, 32); return x; }
__device__ __forceinline__ float wave_max_dpp(float x) { WRED_STEP(wr_max, x, 0xB1); WRED_STEP(wr_max, x, 0x4E); WRED_STEP(wr_max, x, 0x124); WRED_STEP(wr_max, x, 0x128); WRED_SWAP(wr_max, x, 16); WRED_SWAP(wr_max, x, 32); return x; }
template <int NR>
__device__ __forceinline__ void rms_load(f32x4 (&v)[NR][4], const float* const (&xrow)[NR], int lane) {
#pragma unroll
    for (int r = 0; r < NR; ++r) { const GAS f32x4* xr = (const GAS f32x4*)xrow[r] + lane;
#pragma unroll
        for (int j = 0; j < 4; ++j) v[r][j] = __builtin_nontemporal_load(xr + 64 * j); }
}
template <int NR>
__device__ __forceinline__ void rms_finish(f32x4 (&v)[NR][4], const f32x4 (&gv)[4], unsigned char* const (&o8row)[NR], float* const (&rsc)[NR], int lane) {
    float ss[NR], am[NR];
#pragma unroll
    for (int r = 0; r < NR; ++r) { f32x4 s4 = v[r][0] * v[r][0];
#pragma unroll
        for (int j = 1; j < 4; ++j) s4 = __builtin_elementwise_fma(v[r][j], v[r][j], s4);
        ss[r] = (s4[0] + s4[1]) + (s4[2] + s4[3]); }
#pragma unroll
    for (int r = 0; r < NR; ++r) ss[r] = wave_sum_dpp(ss[r]);
#pragma unroll
    for (int r = 0; r < NR; ++r) { const float rs = __builtin_amdgcn_rsqf(ss[r] * (1.f / DM) + 1e-6f);
        f32x4 m4 = {0.f, 0.f, 0.f, 0.f};
#pragma unroll
        for (int j = 0; j < 4; ++j) { v[r][j] = v[r][j] * (gv[j] * rs); m4 = __builtin_elementwise_max(m4, __builtin_elementwise_abs(v[r][j])); }
        am[r] = fmaxf(fmaxf(m4[0], m4[1]), fmaxf(m4[2], m4[3])); }
#pragma unroll
    for (int r = 0; r < NR; ++r) am[r] = fmaxf(wave_max_dpp(am[r]), 1e-30f);
#pragma unroll
    for (int r = 0; r < NR; ++r) { const float qs = 127.0f * __builtin_amdgcn_rcpf(am[r]);
        GAS unsigned* q4 = (GAS unsigned*)o8row[r] + lane;
#pragma unroll
        for (int j = 0; j < 4; ++j) { const f32x4 t = __builtin_elementwise_fma(v[r][j], (f32x4){qs, qs, qs, qs}, (f32x4){12582912.f, 12582912.f, 12582912.f, 12582912.f});
            const unsigned lo = __builtin_amdgcn_perm(__float_as_uint(t[1]), __float_as_uint(t[0]), 0x0c0c0400u), hi = __builtin_amdgcn_perm(__float_as_uint(t[3]), __float_as_uint(t[2]), 0x0c0c0400u);
            q4[64 * j] = __builtin_amdgcn_perm(hi, lo, 0x05040100u); }
        if (lane == 0) *rsc[r] = am[r] * (1.0f / 127.0f); }
}
__device__ __forceinline__ void p0_prologue(Frame& F) {
    LAS float* scr = (LAS float*)(F.lds + RING_OFF + F.wave * 16384);
    const int gw = F.vcu * NWAVES + F.wave, NGW = F.G * NWAVES;
    constexpr int I_OA = (512 / 64) * (DM / 32), I_OUT = (DM / 64) * (DM / 32);
    constexpr int NITEMS = 2 * I_OA + I_OUT;
    { LAS float* red = (LAS float*)(F.lds + RING_OFF + NWAVES * 16384);
      for (int nb = F.vcu; nb < NI8 / 32; nb += F.G) p0_quant_block(F.w_in, DIN, nb, F.WG8, F.CS, scr, red, F.wave, F.lane); }
    for (int it = gw; it < NITEMS; it += NGW) {
        int r = it;
        if (r < I_OA) { p0_transpose_item<0>(F.w_o_a, DM, 0, DM / 32, F.Wo_t, DM, 0, scr, r, F.lane); continue; } r -= I_OA;
        if (r < I_OA) { p0_transpose_item<0>(F.w_o_b, DM, 0, DM / 32, F.Wo_t, DM, 512, scr, r, F.lane); continue; } r -= I_OA;
        p0_transpose_item<0>(F.w_out, DM, 0, DM / 32, F.Wout_t, DM, 0, scr, r, F.lane);
    }
    static_assert(M % 4 == 0 && MP % 4 == 0, "row quads");
    f32x4 gv[4];
    { const GAS f32x4* gr = (const GAS f32x4*)F.norm_g + F.lane;
#pragma unroll
      for (int j = 0; j < 4; ++j) gv[j] = gr[64 * j]; }
    f32x4 va[4][4], vb[4][4];
    auto xrows = [&](int m4, const float* (&xr)[4]) {
#pragma unroll
        for (int r = 0; r < 4; ++r) { const int m = 4 * m4 + r; xr[r] = (m < MP) ? F.xp + (size_t)m * DM : F.xs + (size_t)(m - MP) * DM; } };
    auto finish = [&](f32x4 (&v)[4][4], int m4) { unsigned char* o8[4]; float* rsc[4];
#pragma unroll
        for (int r = 0; r < 4; ++r) { const int m = 4 * m4 + r; o8[r] = F.XN8 + (size_t)m * DM; rsc[r] = F.RSC + m; }
        rms_finish<4>(v, gv, o8, rsc, F.lane); };
    auto load = [&](f32x4 (&v)[4][4], int m4) { const float* xr[4]; xrows(m4, xr); __builtin_amdgcn_sched_barrier(0); rms_load<4>(v, xr, F.lane); __builtin_amdgcn_sched_barrier(0); };
    const int NT = (gw < M / 4) ? (M / 4 - gw + NGW - 1) / NGW : 0;
    auto row0 = [&](int t) { return gw + t * NGW; };
    if (NT == 1) { load(va, row0(0)); finish(va, row0(0)); }
    else if (NT >= 2) {
        load(va, row0(0)); load(vb, row0(1)); finish(va, row0(0));
        int t = 1;
        for (; t + 2 < NT; t += 2) { load(va, row0(t + 1)); finish(vb, row0(t)); load(vb, row0(t + 2)); finish(va, row0(t + 1)); }
        if (NT - t == 2) { load(va, row0(t + 1)); finish(vb, row0(t)); finish(va, row0(t + 1)); }
        else finish(vb, row0(t));
    }
}
__device__ __forceinline__ int t5_bucket(int rel) {
    const int n = rel < 0 ? -rel : rel; int b;
    if (n < 8) b = n; else { const int lg = 31 - __clz(n * n); b = 8 + (lg - 6); b = b > 15 ? 15 : b; }
    return b + (rel > 0 ? 16 : 0);
}
__device__ __forceinline__ float dot8(v4u q, v4u k) {
    return (pg8::bf_lo(q.x) * pg8::bf_lo(k.x) + pg8::bf_hi(q.x) * pg8::bf_hi(k.x)) + (pg8::bf_lo(q.y) * pg8::bf_lo(k.y) + pg8::bf_hi(q.y) * pg8::bf_hi(k.y))
         + (pg8::bf_lo(q.z) * pg8::bf_lo(k.z) + pg8::bf_hi(q.z) * pg8::bf_hi(k.z)) + (pg8::bf_lo(q.w) * pg8::bf_lo(k.w) + pg8::bf_hi(q.w) * pg8::bf_hi(k.w));
}
__device__ __forceinline__ void attn_naive_A(Frame& F) {
    const int gw = F.vcu * NWAVES + F.wave, NGW = F.G * NWAVES, lane = F.lane;
    for (int idx = gw; idx < M * 8; idx += NGW) {
        const int m = idx >> 3, h = idx & 7;
        int base, t, rows;
        if (m < MP) { base = m & ~(SEQ_P - 1); t = m & (SEQ_P - 1); rows = SEQ_P / 64; } else { const int mm = m - MP; base = MP + (mm & ~(SEQ_S - 1)); t = mm & (SEQ_S - 1); rows = SEQ_S / 64; }
        const int r = t >> 6, c = t & 63;
        int rs = r - 4; rs = rs < 0 ? 0 : rs; rs = rs > rows - 8 ? rows - 8 : rs;
        int cs = c - 8; cs = cs < 0 ? 0 : cs; cs = cs > 48 ? 48 : cs;
        const GAS v4u* qp = (const GAS v4u*)(F.QA + (size_t)m * 512 + h * 64);
        v4u qv[8];
#pragma unroll
        for (int i = 0; i < 8; ++i) qv[i] = qp[i];
        float s0, s1;
#pragma unroll
        for (int jj = 0; jj < 2; ++jj) {
            const int j = lane + 64 * jj, kr = rs + (j >> 4), kc = cs + (j & 15), tok = base + kr * 64 + kc;
            const GAS v4u* kp = (const GAS v4u*)(F.KA + (size_t)tok * 512 + h * 64);
            float d = 0.f;
#pragma unroll
            for (int i = 0; i < 8; ++i) d += dot8(qv[i], kp[i]);
            d += F.rpb[(h * 15 + (kr - r + 7)) * 31 + (kc - c + 15)] * pg8::LOG2E;
            if (jj == 0) s0 = d; else s1 = d;
        }
        const float mx = wave_max(fmaxf(s0, s1));
        const float p0 = __builtin_amdgcn_exp2f(s0 - mx), p1 = __builtin_amdgcn_exp2f(s1 - mx);
        const float l = wave_sum(p0 + p1);
        float o = 0.f;
        for (int j = 0; j < 128; ++j) {
            const float pj = __shfl(j < 64 ? p0 : p1, j & 63);
            const int kr = rs + (j >> 4), kc = cs + (j & 15), tok = base + kr * 64 + kc;
            o += pj * bf2f(F.VA[(size_t)tok * 512 + h * 64 + lane]);
        }
        const float z = bf2f(F.ZA[(size_t)m * 512 + h * 64 + lane]);
        F.XN[(size_t)m * 1024 + h * 64 + lane] = (bf16)f2bf(o / l * z);
    }
}
__device__ __forceinline__ void attn_naive_B(Frame& F) {
    const int gw = F.vcu * NWAVES + F.wave, NGW = F.G * NWAVES, lane = F.lane;
    for (int idx = gw; idx < M * 8; idx += NGW) {
        const int m = idx >> 3, h = idx & 7, kvh = h >> 2;
        int base, t, L;
        if (m < MP) { base = m & ~(SEQ_P - 1); t = m & (SEQ_P - 1); L = SEQ_P; } else { const int mm = m - MP; base = MP + (mm & ~(SEQ_S - 1)); t = mm & (SEQ_S - 1); L = SEQ_S; }
        const GAS v4u* qp = (const GAS v4u*)(F.QB + (size_t)m * 512 + h * 64);
        v4u qv[8];
#pragma unroll
        for (int i = 0; i < 8; ++i) qv[i] = qp[i];
        float s[5]; float mxl = -INFINITY;
#pragma unroll
        for (int jj = 0; jj < 5; ++jj) {
            const int rel = -128 + lane + 64 * jj, j = t + rel; const bool valid = rel <= 128 && j >= 0 && j < L;
            float d = -INFINITY;
            if (valid) {
                const GAS v4u* kp = (const GAS v4u*)(F.KVB + (size_t)(base + j) * 256 + kvh * 64);
                d = 0.f;
#pragma unroll
                for (int i = 0; i < 8; ++i) d += dot8(qv[i], kp[i]);
                d += F.t5[t5_bucket(rel) * 8 + h] * pg8::LOG2E;
            }
            s[jj] = d; mxl = fmaxf(mxl, d);
        }
        const float sl = F.sink[h] * pg8::LOG2E;
        const float mx = fmaxf(wave_max(mxl), sl);
        float ps = 0.f;
#pragma unroll
        for (int jj = 0; jj < 5; ++jj) { s[jj] = __builtin_amdgcn_exp2f(s[jj] - mx); ps += s[jj]; }
        const float l = wave_sum(ps) + __builtin_amdgcn_exp2f(sl - mx);
        float o = 0.f;
#pragma unroll
        for (int jj = 0; jj < 5; ++jj) {
            for (int jl = 0; jl < 64; ++jl) {
                const int rel = -128 + jl + 64 * jj, j = t + rel;
                if (rel > 128 || j < 0 || j >= L) continue;
                const float pj = __shfl(s[jj], jl);
                o += pj * bf2f(F.KVB[(size_t)(base + j) * 256 + 128 + kvh * 64 + lane]);
            }
        }
        const float z = bf2f(F.ZB[(size_t)m * 512 + h * 64 + lane]);
        F.XN[(size_t)m * 1024 + 512 + h * 64 + lane] = (bf16)f2bf(o / l * z);
    }
}

namespace att {
typedef short bf16x8 __attribute__((ext_vector_type(8)));
typedef short s16x4 __attribute__((ext_vector_type(4)));
typedef float f32x16 __attribute__((ext_vector_type(16)));
typedef float f32x2_t __attribute__((ext_vector_type(2)));
typedef __bf16 bf16x2_t __attribute__((ext_vector_type(2)));
constexpr int KB_BYTES = 8192, DHS = 4160, VB_BYTES = 2 * DHS, BUF_BYTES = KB_BYTES + VB_BYTES;
#ifndef ATT_DPF
#define ATT_DPF 2
#endif
constexpr int DPF = ATT_DPF, NS = 4;
constexpr int RPB_P = 80;
constexpr int L_KV = 0, L_RPB = 66560, L_T5 = L_RPB + 16 * RPB_P * 4, L_ZO = L_T5 + 12288, L_Q = L_ZO + 32768, L_WSF = L_Q + 32768, L_RED = L_WSF + 2048, L_END = L_RED + 512;
static_assert(NS * BUF_BYTES <= L_RPB && L_END <= ATT_LDS_BYTES, "attention LDS map");
__device__ __forceinline__ constexpr int crow(int r, int hi) { return (r & 3) + 8 * (r >> 2) + 4 * hi; }
__device__ __forceinline__ unsigned cvtpk(float lo, float hi) { f32x2_t v = {lo, hi}; bf16x2_t b = __builtin_convertvector(v, bf16x2_t); return __builtin_bit_cast(unsigned, b); }
__device__ __forceinline__ s16x4 vtr(const LAS char* p) { return __builtin_bit_cast(s16x4, __builtin_amdgcn_ds_read_tr16_b64_v4i16((LAS s16x4*)p)); }
__device__ __forceinline__ int clampi(int v, int lo, int hi) { return v < lo ? lo : (v > hi ? hi : v); }

template <bool MASKED>
__device__ __forceinline__ void subtile(const LAS char* kp, const int (&koff)[4], const LAS char* vp, const LAS float* tab, const f32x16& colmask, const bf16x8 (&qr)[4], f32x16 (&o)[2], float& lsum) {
    bf16x8 kf[4];
#pragma unroll
    for (int d0 = 0; d0 < 4; ++d0) kf[d0] = *(const LAS bf16x8*)(kp + koff[d0]);
    f32x16 s;
#pragma unroll
    for (int r = 0; r < 16; ++r) s[r] = tab[crow(r, 0)];
    s16x4 vl[2][2], vh[2][2];
#pragma unroll
    for (int dh = 0; dh < 2; ++dh)
#pragma unroll
        for (int ks = 0; ks < 2; ++ks) { vl[dh][ks] = vtr(vp + dh * DHS + ks * 1024); vh[dh][ks] = vtr(vp + dh * DHS + ks * 1024 + 512); }
    if (MASKED) {
#pragma unroll
        for (int r = 0; r < 16; ++r) s[r] += colmask[r]; }
#pragma unroll
    for (int d0 = 0; d0 < 4; ++d0) s = __builtin_amdgcn_mfma_f32_32x32x16_bf16(kf[d0], qr[d0], s, 0, 0, 0);
    typedef float f32x2_ __attribute__((ext_vector_type(2)));
    f32x2_ a01 = {0.f, 0.f};
#pragma unroll
    for (int r = 0; r < 16; r += 2) { s[r] = __builtin_amdgcn_exp2f(s[r]); s[r + 1] = __builtin_amdgcn_exp2f(s[r + 1]); a01 += (f32x2_){s[r], s[r + 1]}; }
    lsum += a01[0] + a01[1];
    v4u pw0, pw1;
    pw0.x = cvtpk(s[0], s[1]); pw0.y = cvtpk(s[2], s[3]); pw0.z = cvtpk(s[4], s[5]); pw0.w = cvtpk(s[6], s[7]);
    pw1.x = cvtpk(s[8], s[9]); pw1.y = cvtpk(s[10], s[11]); pw1.z = cvtpk(s[12], s[13]); pw1.w = cvtpk(s[14], s[15]);
#pragma unroll
    for (int dh = 0; dh < 2; ++dh) {
        const bf16x8 v0 = (bf16x8){vl[dh][0][0], vl[dh][0][1], vl[dh][0][2], vl[dh][0][3], vh[dh][0][0], vh[dh][0][1], vh[dh][0][2], vh[dh][0][3]};
        const bf16x8 v1 = (bf16x8){vl[dh][1][0], vl[dh][1][1], vl[dh][1][2], vl[dh][1][3], vh[dh][1][0], vh[dh][1][1], vh[dh][1][2], vh[dh][1][3]};
        o[dh] = __builtin_amdgcn_mfma_f32_32x32x16_bf16(__builtin_bit_cast(bf16x8, pw0), v0, o[dh], 0, 0, 0);
        o[dh] = __builtin_amdgcn_mfma_f32_32x32x16_bf16(__builtin_bit_cast(bf16x8, pw1), v1, o[dh], 0, 0, 0);
    }
}

__device__ __forceinline__ void wave_epilogue(LAS char* L, int wave, int lane, f32x16 (&o)[2], float l, bf16* OG, int tok0, int tok1, int ocol) {
    const int r32 = lane & 31, hi = lane >> 5;
    LAS float* wsf = (LAS float*)(L + L_WSF) + wave * 64;
    LAS bf16* stg = (LAS bf16*)(L + L_ZO) + wave * 2048;
    if (hi == 0) wsf[r32] = __builtin_amdgcn_rcpf(l);
    LDS_WAIT();
#pragma unroll
    for (int r = 0; r < 16; r += 2) {
        const int orow0 = crow(r, 0) + 4 * hi, orow1 = crow(r + 1, 0) + 4 * hi; const float rl0 = wsf[orow0], rl1 = wsf[orow1];
#pragma unroll
        for (int dh = 0; dh < 2; ++dh) { const int i0 = orow0 * 64 + dh * 32 + r32, i1 = orow1 * 64 + dh * 32 + r32; const float z0 = bf2f(stg[i0]), z1 = bf2f(stg[i1]);
            const unsigned pk = pg8::cvt_pk_bf16(o[dh][r] * rl0 * z0 * pg8::sigmoidf_(z0), o[dh][r + 1] * rl1 * z1 * pg8::sigmoidf_(z1));
            stg[i0] = (bf16)(pk & 0xffffu); stg[i1] = (bf16)(pk >> 16); } }
    LDS_WAIT();
#pragma unroll
    for (int i = 0; i < 4; ++i) { const int row = i * 8 + (lane >> 3), ch = lane & 7; const int tok = (row < 16 ? tok0 : tok1 - 16) + row;
        const v4u v = *(const LAS v4u*)(stg + row * 64 + ch * 8);
        *(GAS v4u*)(OG + (size_t)tok * 1024 + ocol + ch * 8) = v; }
    LDS_WAIT();
}

__device__ __forceinline__ void setup_global(Frame& F, LAS char* L, float* T5G) {
    const int tid = F.tid; LAS float* red = (LAS float*)(L + L_RED);
    float mx[6] = {0.f, 0.f, 0.f, 0.f, 0.f, 0.f};
    if (tid < 64) { mx[0] = fabsf(F.qn_a[tid]); mx[1] = fabsf(F.kn_a[tid]); mx[2] = fabsf(F.qn_b[tid]); mx[3] = fabsf(F.kn_b[tid]); }
    for (int i = tid; i < 8 * 15 * 31; i += NWAVES * 64) mx[4] = fmaxf(mx[4], fabsf(F.rpb[i]));
    if (tid < 256) mx[5] = fabsf(F.t5[tid]);
    if (tid < 8) mx[5] = fmaxf(mx[5], fabsf(F.sink[tid]));
#pragma unroll
    for (int k = 0; k < 6; ++k) { const float v = wave_max(mx[k]); if (F.lane == 0) red[F.wave * 6 + k] = v; }
    __syncthreads();
#pragma unroll
    for (int k = 0; k < 6; ++k) { float v = 0.f;
#pragma unroll
        for (int w = 0; w < NWAVES; ++w) v = fmaxf(v, red[w * 6 + k]); mx[k] = v; }
    const float M0a = pg8::C2 * 64.f * mx[0] * mx[1] + pg8::LOG2E * mx[4], M0b = pg8::C2 * 64.f * mx[2] * mx[3] + pg8::LOG2E * mx[5];
    for (int i = tid; i < 8 * 384; i += NWAVES * 64) { const int h = i / 384, rel = (i % 384) - 192; const int n = rel < 0 ? -rel : rel;
        T5G[i] = (n <= 128) ? F.t5[t5_bucket(rel) * 8 + h] * pg8::LOG2E - M0b : -INFINITY; }
    __syncthreads();
    if (tid == 0) { T5G[3072] = M0b; T5G[3073] = M0a; }
    __syncthreads();
}
__device__ __forceinline__ void setup(Frame& F, LAS char* L, const float* T5G) {
    LAS float* red = (LAS float*)(L + L_RED); LAS float* t5L = (LAS float*)(L + L_T5);
    for (int i = F.tid; i < 8 * 384; i += NWAVES * 64) t5L[i] = T5G[i];
    if (F.tid == 0) { red[48] = T5G[3072]; red[49] = T5G[3073]; }
    __syncthreads();
}


__device__ __forceinline__ void glds16(const void* gsrc, unsigned lds_dst) { unsigned keep;
    asm volatile("s_mov_b32 %0, m0\n\ts_mov_b32 m0, %2\n\ts_nop 0\n\tglobal_load_lds_dwordx4 %1, off\n\ts_mov_b32 m0, %0" : "=&s"(keep) : "v"(gsrc), "s"(lds_dst) : "memory"); }
#define ATT_WAIT_BAR(N) asm volatile("s_waitcnt vmcnt(" #N ") lgkmcnt(0)\n\ts_barrier" ::: "memory")
#define ATT_WB_CASE(N) case N: ATT_WAIT_BAR(N); break;
__device__ __forceinline__ void wait_bar(int n) {
    switch (n < 0 ? 0 : (n > 20 ? 20 : n)) { ATT_WB_CASE(0) ATT_WB_CASE(1) ATT_WB_CASE(2) ATT_WB_CASE(3) ATT_WB_CASE(4) ATT_WB_CASE(5) ATT_WB_CASE(6) ATT_WB_CASE(7) ATT_WB_CASE(8) ATT_WB_CASE(9) ATT_WB_CASE(10)
        ATT_WB_CASE(11) ATT_WB_CASE(12) ATT_WB_CASE(13) ATT_WB_CASE(14) ATT_WB_CASE(15) ATT_WB_CASE(16) ATT_WB_CASE(17) ATT_WB_CASE(18) ATT_WB_CASE(19) default: ATT_WAIT_BAR(20); break; } }
#define ATT_WV_CASE(N) case N: asm volatile("s_waitcnt vmcnt(" #N ")" ::: "memory"); break;
__device__ __forceinline__ void wait_vm(int n) {
    switch (n < 0 ? 0 : (n > 20 ? 20 : n)) { ATT_WV_CASE(0) ATT_WV_CASE(1) ATT_WV_CASE(2) ATT_WV_CASE(3) ATT_WV_CASE(4) ATT_WV_CASE(5) ATT_WV_CASE(6) ATT_WV_CASE(7) ATT_WV_CASE(8) ATT_WV_CASE(9) ATT_WV_CASE(10)
        ATT_WV_CASE(11) ATT_WV_CASE(12) ATT_WV_CASE(13) ATT_WV_CASE(14) ATT_WV_CASE(15) ATT_WV_CASE(16) ATT_WV_CASE(17) ATT_WV_CASE(18) ATT_WV_CASE(19) default: asm volatile("s_waitcnt vmcnt(20)" ::: "memory"); break; } }
struct VmBook {
    int since_pair, since_z, since_q;
    __device__ __forceinline__ void init() { since_pair = since_z = since_q = 1 << 20; }
    __device__ __forceinline__ void issued(int n) { since_pair += n; since_z += n; since_q += n; }
};
__device__ __forceinline__ void dma_rows32(const bf16* p_lane, size_t pitch8, unsigned dst) {
#pragma unroll
    for (int i = 0; i < 4; ++i) glds16(p_lane + i * pitch8, (unsigned)__builtin_amdgcn_readfirstlane(dst + i * 1024));
}

__device__ __forceinline__ void decodeA(int ui, int& h, int& rows, int& base, int& r0) {
    int seq, rg;
    if (ui < 1024) { seq = ui >> 7; h = (ui >> 4) & 7; rg = ((ui & 15) + 4 * (ui >> 8)) & 15; rows = SEQ_P / 64; base = seq * SEQ_P; }
    else { const int u2 = ui - 1024; seq = u2 >> 8; h = (u2 >> 5) & 7; rg = ((u2 & 31) + 4 * seq + 2) & 31; rows = SEQ_S / 64; base = MP + seq * SEQ_S; }
    r0 = 4 * rg;
}
__device__ __forceinline__ void build_rpb(Frame& F, LAS char* L, int h) {
    LAS float* rpbL = (LAS float*)(L + L_RPB); const float M0a = ((const LAS float*)(L + L_RED))[49];
    for (int i = F.tid; i < 16 * 64; i += NWAVES * 64) { const int row = i >> 6, col = i & 63;
        float v = 0.f; if (row == 15) v = -INFINITY; else if (col >= 16 && col <= 46) v = F.rpb[(h * 15 + row) * 31 + (col - 16)] * pg8::LOG2E - M0a;
        rpbL[row * RPB_P + col] = v; }
}
__device__ __forceinline__ int rotA(int a, int T) { const int r0 = ((a + 11) / 12) * 12; return (r0 < a + T) ? r0 - a : 0; }
__device__ __forceinline__ int rowA(int a, int T, int k0, int p) { return (p < T - k0) ? a + k0 + p : a + p - (T - k0); }
struct CursorA {
    int u, t, T, k0; const bf16* pk; const bf16* pv;
    __device__ __forceinline__ void load_unit(const Frame& F, int klo, int vlo) {
        int h, rows, base, r0; decodeA(u, h, rows, base, r0);
        const int rs_lo = clampi(r0 - 4, 0, rows - 8), rs_hi = clampi(r0 - 1, 0, rows - 8) + 8; T = rs_hi - rs_lo; t = 0; k0 = rotA(rs_lo, T);
        const size_t tok = (size_t)(base + rs_lo * 64);
        pk = F.KA + tok * 512 + h * 64 + klo; pv = F.VA + tok * 512 + h * 64 + vlo;
    }
};
#define ATT_DMA(cur, slot) do { const unsigned so_ = (unsigned)(slot) * BUF_BYTES; glds16((cur).pk, (unsigned)__builtin_amdgcn_readfirstlane(kdst + so_)); glds16((cur).pv, (unsigned)__builtin_amdgcn_readfirstlane(vdst + so_)); } while (0)
#define ATT_QFRAGS() do { _Pragma("unroll") for (int d0 = 0; d0 < 4; ++d0) qr[d0] = *(const LAS bf16x8*)(L + L_Q + w * 4096 + r32 * 128 + (2 * d0 + hi) * 16); } while (0)

template <bool DO_COMPUTE = true, bool DO_EPI = true>
__device__ __forceinline__ void phase_A(Frame& F, LAS char* L) {
    const int lane = F.lane, w = F.wave, r32 = lane & 31, hi = lane >> 5;
    const int rp = w >> 2, cb = w & 3, c0 = 16 * cb, cw = (cb == 0) ? 0 : (cb == 1) ? 8 : (cb == 2) ? 24 : 32;
    const int c = c0 + (r32 & 15);
    const int lo = clampi(c - 8, 0, 48) - cw;
    f32x16 colmask;
#pragma unroll
    for (int r = 0; r < 16; ++r) colmask[r] = ((unsigned)(crow(r, 0) + 4 * hi - lo) < 16u) ? 0.f : -INFINITY;
    int koff[4];
    { const int row = cw + r32;
#pragma unroll
      for (int d0 = 0; d0 < 4; ++d0) koff[d0] = row * 128 + (((2 * d0 + hi) ^ ((row >> 1) & 7)) << 4); }
    const int voff = KB_BYTES + (cw + 4 * hi + ((lane & 15) >> 2)) * 64 + ((lane >> 4) & 1) * 32 + (lane & 3) * 8;
    const int krow = 8 * w + (lane >> 3), klo = krow * 512 + (((lane & 7) ^ ((krow >> 1) & 7)) << 3);
    const int vlo = (16 * (w & 3) + (lane >> 2)) * 512 + (w >> 2) * 32 + (lane & 3) * 8;
    const unsigned lds0 = (unsigned)(uintptr_t)L;
    const unsigned kdst = lds0 + L_KV + w * 1024, vdst = lds0 + L_KV + KB_BYTES + (w >> 2) * DHS + (w & 3) * 1024;
    const unsigned qdst = lds0 + L_Q + w * 4096, zdst = lds0 + L_ZO + w * 4096;
    const int qz_lane = (lane >> 3) * 512 + (lane & 7) * 8;
    const LAS float* rpbL = (const LAS float*)(L + L_RPB);
    const int NU = 3072;
    CursorA cur; cur.u = F.vcu; cur.load_unit(F, klo, vlo);
    int cur_h; { int rows_, base_, r0_; decodeA(F.vcu, cur_h, rows_, base_, r0_); }
    build_rpb(F, L, cur_h);
#define ATT_A_PIECE(P, uu, dst, i) do { int h_, rows_, base_, r0_; decodeA((uu), h_, rows_, base_, r0_); \
        glds16((P) + (size_t)(base_ + (r0_ + 2 * rp) * 64 + c0 + ((i) >> 1) * 64 + ((i) & 1) * 8) * 512 + h_ * 64 + qz_lane, (unsigned)__builtin_amdgcn_readfirstlane((dst) + (i) * 1024)); } while (0)
    VmBook vb; vb.init();
#pragma unroll
    for (int i = 0; i < 4; ++i) ATT_A_PIECE(F.QA, F.vcu, qdst, i);
    vb.issued(4); vb.since_q = 0;
    bool more = true; int wslot = 0, rslot = 0;
#define ATT_ISSUE_TILE() do { { const size_t ro_ = (size_t)(rowA(0, cur.T, cur.k0, cur.t)) * (64 * 512); const unsigned so_ = (unsigned)wslot * BUF_BYTES; \
            glds16(cur.pk + ro_, (unsigned)__builtin_amdgcn_readfirstlane(kdst + so_)); glds16(cur.pv + ro_, (unsigned)__builtin_amdgcn_readfirstlane(vdst + so_)); } \
        wslot = (wslot + 1) & (NS - 1); vb.issued(2); vb.since_pair = 0; \
        if (cur.t + 1 < cur.T) { ++cur.t; } else if (cur.u + F.G < NU) { cur.u += F.G; cur.load_unit(F, klo, vlo); } else { more = false; } } while (0)
    { const int np0 = (cur.T - cur.t >= 2) ? 2 : 1; ATT_ISSUE_TILE(); if (np0 == 2) ATT_ISSUE_TILE(); }
    for (int ui = F.vcu; ui < NU; ui += F.G) {
        int h, rows, base, r0; decodeA(ui, h, rows, base, r0);
        const int rs_lo = clampi(r0 - 4, 0, rows - 8), rs_hi = clampi(r0 - 1, 0, rows - 8) + 8, T = rs_hi - rs_lo;
        const int rA = r0 + 2 * rp, r = rA + (r32 >> 4);
        const int rs_r = clampi(r - 4, 0, rows - 8), k0 = rotA(rs_lo, T);
        const int rs_w0 = clampi(rA - 4, 0, rows - 8), rs_w1 = clampi(rA - 3, 0, rows - 8) + 8;
        if (h != cur_h) { ATT_WAIT_BAR(0); build_rpb(F, L, h); cur_h = h; ATT_WAIT_BAR(0); }
        f32x16 o[2]; o[0] = f32x16{}; o[1] = f32x16{}; float lsum = 0.f;
        bf16x8 qr[4];
        const int un = (ui + F.G < NU) ? ui + F.G : ui;
        int ss = 0;
        for (int t = 0; t < T; ++ss) {
            const int n = (T - t >= 2) ? 2 : 1;
            { int w_ = vb.since_pair; if (ss == 0 && vb.since_q < w_) w_ = vb.since_q; wait_bar(w_); }
            if (ss == 0) ATT_QFRAGS();
            const int np = more ? ((cur.T - cur.t >= 2) ? 2 : 1) : 0;
            if (np >= 1) ATT_ISSUE_TILE();
#pragma unroll
            for (int i = 0; i < 2; ++i) if (i < n) {
                const LAS char* buf = L + L_KV + ((rslot + i) & (NS - 1)) * BUF_BYTES;
                const int kr = rowA(rs_lo, T, k0, t + i);
                const bool valid = kr >= rs_r && kr < rs_r + 8; const int trow = valid ? kr - r + 7 : 15;
                const LAS float* tab = rpbL + (trow * RPB_P + 16 + cw - c + 15 + 4 * hi);
                if (DO_COMPUTE && kr >= rs_w0 && kr < rs_w1) subtile<true>(buf, koff, buf + voff, tab, colmask, qr, o, lsum);
                if (i == 0 && np >= 2) ATT_ISSUE_TILE();
            }
            if (ss == 0) {
#pragma unroll
                for (int i = 0; i < 4; ++i) ATT_A_PIECE(F.ZA, ui, zdst, i);
                vb.issued(4); vb.since_z = 0; }
            if (ss == 1) {
#pragma unroll
                for (int i = 0; i < 4; ++i) ATT_A_PIECE(F.QA, un, qdst, i);
                vb.issued(4); vb.since_q = 0; }
            rslot = (rslot + n) & (NS - 1); t += n;
        }
        { auto rr = __builtin_amdgcn_permlane32_swap(__float_as_uint(lsum), __float_as_uint(lsum), false, false); lsum = __uint_as_float(rr[0]) + __uint_as_float(rr[1]); }
        const int tok0 = base + rA * 64 + c0;
        wait_vm(vb.since_z);
        if (DO_EPI) { wave_epilogue(L, w, lane, o, lsum, F.XN, tok0, tok0 + 64, h * 64); vb.issued(4); }
    }
    ATT_WAIT_BAR(0);
#undef ATT_ISSUE_TILE
#undef ATT_A_PIECE
}

__device__ __forceinline__ void decodeB(int ui, int& kvh, int& Ls, int& base, int& p0) {
    int seq, pb;
    if (ui < 1024) { seq = ui >> 7; kvh = (ui >> 6) & 1; pb = ui & 63; Ls = SEQ_P; base = seq * SEQ_P; }
    else { const int u2 = ui - 1024; seq = u2 >> 8; kvh = (u2 >> 7) & 1; pb = u2 & 127; Ls = SEQ_S; base = MP + seq * SEQ_S; }
    p0 = 64 * pb;
}
struct CursorB {
    int u, t, T; const bf16* pk; const bf16* pv;
    __device__ __forceinline__ void load_unit(const Frame& F, int klo, int vlo) {
        int kvh, Ls, base, p0; decodeB(u, kvh, Ls, base, p0);
        int t_lo = 0, t_hi = 5; if (p0 < 128) t_lo = (128 - p0) >> 6; if (p0 + 192 > Ls) t_hi = 5 - ((p0 + 192 - Ls) >> 6);
        t = t_lo; T = t_hi;
        const long tok = (long)base + p0 - 128 + 64 * t_lo;
        pk = F.KVB + tok * 256 + kvh * 64 + klo; pv = F.KVB + tok * 256 + 128 + kvh * 64 + vlo;
    }
    __device__ __forceinline__ void advance(const Frame& F, int klo, int vlo, int NU) {
        if (t + 1 < T) { ++t; pk += 64 * 256; pv += 64 * 256; }
        else if (u + F.G < NU) { u += F.G; load_unit(F, klo, vlo); }
    }
};

__device__ __forceinline__ void phase_B(Frame& F, LAS char* L) {
    const int lane = F.lane, w = F.wave, r32 = lane & 31, hi = lane >> 5;
    const int gq = w >> 1, half = w & 1;
    int koff[4];
#pragma unroll
    for (int d0 = 0; d0 < 4; ++d0) koff[d0] = r32 * 128 + (((2 * d0 + hi) ^ ((r32 >> 1) & 7)) << 4);
    const int voff = KB_BYTES + (4 * hi + ((lane & 15) >> 2)) * 64 + ((lane >> 4) & 1) * 32 + (lane & 3) * 8;
    const int krow = 8 * w + (lane >> 3), klo = krow * 256 + (((lane & 7) ^ ((krow >> 1) & 7)) << 3);
    const int vlo = (16 * (w & 3) + (lane >> 2)) * 256 + (w >> 2) * 32 + (lane & 3) * 8;
    const unsigned lds0 = (unsigned)(uintptr_t)L;
    const unsigned kdst = lds0 + L_KV + w * 1024, vdst = lds0 + L_KV + KB_BYTES + (w >> 2) * DHS + (w & 3) * 1024;
    const unsigned qdst = lds0 + L_Q + w * 4096, zdst = lds0 + L_ZO + w * 4096;
    const int qz_lane = (lane >> 3) * 512 + (lane & 7) * 8;
    const LAS float* t5L = (const LAS float*)(L + L_T5);
    const float M0b = ((const LAS float*)(L + L_RED))[48];
    const float sink_e0 = __builtin_amdgcn_exp2f(F.sink[gq] * pg8::LOG2E - M0b), sink_e1 = __builtin_amdgcn_exp2f(F.sink[4 + gq] * pg8::LOG2E - M0b);
    const f32x16 dummy = f32x16{};
    const int NU = 3072;
    CursorB cur; cur.u = F.vcu; cur.load_unit(F, klo, vlo);
#define ATT_B_PIECE(P, uu, dst, i) do { int kvh_, Ls_, base_, p0_; decodeB((uu), kvh_, Ls_, base_, p0_); \
        glds16((P) + (size_t)(base_ + p0_ + 32 * half + 8 * (i)) * 512 + (kvh_ * 4 + gq) * 64 + qz_lane, (unsigned)__builtin_amdgcn_readfirstlane((dst) + (i) * 1024)); } while (0)
    VmBook vb; vb.init();
#pragma unroll
    for (int i = 0; i < 4; ++i) ATT_B_PIECE(F.QB, F.vcu, qdst, i);
    vb.issued(4); vb.since_q = 0;
    bool more = true; int wslot = 0, rslot = 0;
#define ATT_ISSUE_TILE() do { ATT_DMA(cur, wslot); wslot = (wslot + 1) & (NS - 1); vb.issued(2); vb.since_pair = 0; \
        if (cur.t + 1 < cur.T) { ++cur.t; cur.pk += 64 * 256; cur.pv += 64 * 256; } else if (cur.u + F.G < NU) { cur.u += F.G; cur.load_unit(F, klo, vlo); } else { more = false; } } while (0)
    { const int np0 = (cur.T - cur.t >= 2) ? 2 : 1; ATT_ISSUE_TILE(); if (np0 == 2) ATT_ISSUE_TILE(); }
    for (int ui = F.vcu; ui < NU; ui += F.G) {
        int kvh, Ls, base, p0; decodeB(ui, kvh, Ls, base, p0);
        const int h = kvh * 4 + gq, pq = p0 + 32 * half, qpos = pq + r32;
        int t_lo = 0, t_hi = 5; if (p0 < 128) t_lo = (128 - p0) >> 6; if (p0 + 192 > Ls) t_hi = 5 - ((p0 + 192 - Ls) >> 6);
        f32x16 o[2]; o[0] = f32x16{}; o[1] = f32x16{}; float lsum = 0.f;
        bf16x8 qr[4];
        const int un = (ui + F.G < NU) ? ui + F.G : ui;
        int ss = 0;
        for (int t = t_lo; t < t_hi; ++ss) {
            const int n = (t_hi - t >= 2) ? 2 : 1;
            { int w_ = vb.since_pair; if (ss == 0 && vb.since_q < w_) w_ = vb.since_q; wait_bar(w_); }
            if (ss == 0) ATT_QFRAGS();
            const int np = more ? ((cur.T - cur.t >= 2) ? 2 : 1) : 0;
            if (np >= 1) ATT_ISSUE_TILE();
#pragma unroll
            for (int i = 0; i < 2; ++i) if (i < n) {
                const LAS char* buf = L + L_KV + ((rslot + i) & (NS - 1)) * BUF_BYTES;
                const LAS float* tab0 = t5L + (h * 384 + (p0 - 128 + 64 * (t + i)) - qpos + 192 + 4 * hi);
                subtile<false>(buf, koff, buf + voff, tab0, dummy, qr, o, lsum);
                if (i == 0 && np >= 2) ATT_ISSUE_TILE();
                subtile<false>(buf + 4096, koff, buf + voff + 2048, tab0 + 32, dummy, qr, o, lsum);
                if (i == 0) {
                    if (ss == 0) {
#pragma unroll
                        for (int k = 0; k < 4; ++k) ATT_B_PIECE(F.ZB, ui, zdst, k);
                        vb.issued(4); vb.since_z = 0; }
                    if (ss == 1) {
#pragma unroll
                        for (int k = 0; k < 4; ++k) ATT_B_PIECE(F.QB, un, qdst, k);
                        vb.issued(4); vb.since_q = 0; }
                }
            }
            rslot = (rslot + n) & (NS - 1); t += n;
        }
        { auto rr = __builtin_amdgcn_permlane32_swap(__float_as_uint(lsum), __float_as_uint(lsum), false, false); lsum = __uint_as_float(rr[0]) + __uint_as_float(rr[1]); }
        lsum += kvh ? sink_e1 : sink_e0;
        const int tok0 = base + pq;
        wait_vm(vb.since_z);
        wave_epilogue(L, w, lane, o, lsum, F.XN, tok0, tok0 + 16, 512 + h * 64); vb.issued(4);
    }
    ATT_WAIT_BAR(0);
#undef ATT_ISSUE_TILE
#undef ATT_B_PIECE
}
#undef ATT_DMA
#undef ATT_QFRAGS
}

#ifndef MK_N_LAUNCHES
#define MK_N_LAUNCHES 1
#endif
constexpr int N_PHASES = 5;
constexpr int N_LAUNCHES = MK_N_LAUNCHES;
struct Args { const float* in[14]; float* out; unsigned char* ws; int ph_lo, ph_hi; };
__global__ void __launch_bounds__(NWAVES * 64, 2) enc_fwd(Args args) {
    extern __shared__ __attribute__((aligned(16))) unsigned char lds[];
    Frame F;
    F.lds = (LAS unsigned char*)lds;
    F.MISC = (volatile LAS unsigned*)(F.lds + MISC_OFF);
    F.tid = threadIdx.x; F.lane = F.tid & 63; F.wave = __builtin_amdgcn_readfirstlane(F.tid >> 6);
    F.G = gridDim.x; { const int bx = blockIdx.x; F.vcu = (F.G % 8 == 0) ? (bx % 8) * (F.G / 8) + bx / 8 : bx; }
    unsigned char* ws = args.ws;
    F.ctl = (gu32*)(ws + WS_CTL);
    F.xp = args.in[0]; F.xs = args.in[1]; F.norm_g = args.in[2]; F.w_in = args.in[3]; F.qn_a = args.in[4]; F.kn_a = args.in[5]; F.rpb = args.in[6];
    F.qn_b = args.in[7]; F.kn_b = args.in[8]; F.sink = args.in[9]; F.w_o_a = args.in[10]; F.w_o_b = args.in[11]; F.w_out = args.in[12]; F.t5 = args.in[13];
    F.out = args.out;
    F.Win_t = (bf16*)(ws + WS_WIN); F.Wo_t = (bf16*)(ws + WS_WO); F.Wout_t = (bf16*)(ws + WS_WOUT);
    F.XN = (bf16*)(ws + WS_XN); F.QA = (bf16*)(ws + WS_QA); F.KA = (bf16*)(ws + WS_KA); F.VA = (bf16*)(ws + WS_VA); F.ZA = (bf16*)(ws + WS_ZA);
    F.QB = (bf16*)(ws + WS_QB); F.ZB = (bf16*)(ws + WS_ZB); F.KVB = (bf16*)(ws + WS_KVB); F.MRG = (bf16*)(ws + WS_MRG); F.XN8 = ws + WS_XN8; F.WG8 = ws + WS_WG8; F.RSC = (float*)(ws + WS_RSC); F.CS = (float*)(ws + WS_RSC + 512 * 1024);
    bf16* Gt = (bf16*)args.out;
    for (int u = F.tid; u < (LDS_BYTES - LDSCTL_OFF) / 4; u += NWAVES * 64) ((LAS unsigned*)(F.lds + LDSCTL_OFF))[u] = 0u;
    __syncthreads();
    XcdBarrier bar; bar.bar = (unsigned*)(F.ctl + CW_BAR); bar.x = 0; bar.st = nullptr;
    if (N_LAUNCHES == 1) bar = xcd_barrier_post((unsigned*)(F.ctl + CW_BAR), F.MISC + 8);
    const int lo = args.ph_lo, hi = args.ph_hi;
#define IN(k) (lo <= (k) && (k) < hi)
#define SEAM(k) do { if (IN(k) && IN((k) + 1)) xcd_barrier(bar); } while (0)

    float* T5G = (float*)(ws + WS_RSC + 1024 * 1024);
    if (IN(0)) { p0_prologue(F); if (F.vcu == F.G - 1) { __syncthreads(); att::setup_global(F, (LAS char*)(F.lds + RING_OFF), T5G); } SEAM(0); }
    if (IN(1)) {
        { pg8::Gemm g{(const bf16*)F.XN8, (const bf16*)F.WG8, 512, 512, 512}; pg8::StaticOrder S; S.init(M, NI8, F.G, (int)blockIdx.x); S.rot = 1;

          LAS float* csL = (LAS float*)(F.lds + RING_BYTES); LAS float* wL = csL + NI8;
          for (int i = F.tid; i < NI8; i += NWAVES * 64) csL[i] = F.CS[i];
          if (F.tid < 256) { const float* wsrc = (F.tid < 64) ? F.qn_a : (F.tid < 128) ? F.kn_a : (F.tid < 192) ? F.qn_b : F.kn_b; wL[F.tid] = wsrc[F.tid & 63]; }
          __syncthreads();
          pg8::EpiProjI8 E{F.QA, F.KA, F.VA, F.ZA, F.QB, F.KVB, F.ZB, (unsigned char*)Gt, wL, F.RSC, csL, wL + 256};
          pg8::gemm_phase<pg8::EpiProjI8, pg8::StaticOrder, true, true, true>(F.lds + RING_OFF, g, S, E); }
        SEAM(1);
    }
    if (IN(2)) {
#if defined(ATT_NAIVE)
        attn_naive_A(F); attn_naive_B(F);
#else
        LAS char* L = (LAS char*)(F.lds + RING_OFF);
        att::setup(F, L, T5G); att::phase_A(F, L); att::phase_B(F, L);
#endif
        SEAM(2);
    }
    if (IN(3)) {
        pg8::Gemm g{F.XN, F.Wo_t, DM, DM, 512}; pg8::StaticOrder S; S.init(M, DM, F.G, (int)blockIdx.x, 2);
        if (F.G == 256) { S.glob = 1; S.rev = 1; }
        pg8::EpiMerge E{F.MRG, (const unsigned char*)Gt};
        pg8::gemm_phase<pg8::EpiMerge, pg8::StaticOrder, true, true>(F.lds + RING_OFF, g, S, E);
        SEAM(3);
    }
    if (IN(4)) {
        pg8::Gemm g{F.MRG, F.Wout_t, DM, DM, DM}; pg8::StaticOrder S; S.init(M, DM, F.G, (int)blockIdx.x); if (F.G == 256) { S.glob = 1; S.rev = 0; }
        pg8::EpiOut E{F.xp, F.xs, F.out, MP};
        pg8::gemm_phase<pg8::EpiOut, pg8::StaticOrder, true, true>(F.lds + RING_OFF, g, S, E);
    }
#undef IN
#undef SEAM
}

extern "C" void kernel_launch(void* const* d_in, const int* in_sizes, int n_in, void* d_out, int out_size, void* d_ws, size_t ws_size, hipStream_t stream) {
    static int grid = 0;
    if (grid == 0) {
        if (n_in != 14 || in_sizes[0] != MP * DM || in_sizes[1] != MS * DM || out_size != M * DM || ws_size < WS_END) {
            fprintf(stderr, "kernel_launch: unexpected shapes: n_in %d in0 %d in1 %d out %d ws %zu (need %zu); nothing launched\n", n_in, n_in > 0 ? in_sizes[0] : -1, n_in > 1 ? in_sizes[1] : -1, out_size, ws_size, (size_t)WS_END); grid = -1; return; }
        int dev = 0, cus = 0, per_cu = 0;
        if (hipGetDevice(&dev) != hipSuccess || hipDeviceGetAttribute(&cus, hipDeviceAttributeMultiprocessorCount, dev) != hipSuccess) { fprintf(stderr, "kernel_launch: device query failed\n"); grid = -1; return; }
        if (hipFuncSetAttribute((const void*)enc_fwd, hipFuncAttributeMaxDynamicSharedMemorySize, LDS_BYTES) != hipSuccess) { fprintf(stderr, "kernel_launch: hipFuncSetAttribute failed\n"); grid = -1; return; }
        if (hipOccupancyMaxActiveBlocksPerMultiprocessor(&per_cu, (const void*)enc_fwd, NWAVES * 64, LDS_BYTES) != hipSuccess || per_cu < 1) {
            fprintf(stderr, "kernel_launch: occupancy query reports %d workgroups per CU; nothing launched\n", per_cu); (void)hipGetLastError(); grid = -1; return; }
        grid = cus;
    }
    if (grid < 0) return;
    if (hipMemsetAsync((char*)d_ws + WS_CTL, 0, CTL_ZERO_BYTES, stream) != hipSuccess) { fprintf(stderr, "kernel_launch: memset failed\n"); return; }
    Args a{};
    for (int i = 0; i < 14; ++i) a.in[i] = (const float*)d_in[i];
    a.out = (float*)d_out; a.ws = (unsigned char*)d_ws;
    if (N_LAUNCHES == 1) {
        a.ph_lo = 0; a.ph_hi = N_PHASES;
        void* kargs[] = {&a};
        hipError_t e = hipLaunchCooperativeKernel((const void*)enc_fwd, dim3(grid), dim3(NWAVES * 64), kargs, LDS_BYTES, stream);
        if (e != hipSuccess) fprintf(stderr, "kernel_launch: cooperative launch failed: %s (grid %d)\n", hipGetErrorString(e), grid);
    } else {
        for (int li = 0; li < N_PHASES; ++li) {
            a.ph_lo = li; a.ph_hi = li + 1;
            hipLaunchKernelGGL(enc_fwd, dim3(grid), dim3(NWAVES * 64), LDS_BYTES, stream, a);
        }
    }
}
```
